# Optimizing an MI355X kernel written in HIP

```python
import math
import numpy as np
import jax
import jax.numpy as jnp
from jax import lax

D_MODEL = 2048
BATCH = 1
SEQ = 16384
DEPTH = 2

HEAD_DIM = 128
MIX_HEADS = D_MODEL // HEAD_DIM
MIX_W = MIX_HEADS * HEAD_DIM
QBLOCK = 128
NORM_EPS = 1e-6
RET_HEADS = MIX_HEADS // 2
FOX_HEADS = MIX_HEADS - RET_HEADS
RET_W = RET_HEADS * HEAD_DIM
FOX_W = FOX_HEADS * HEAD_DIM
RET_CHUNK = 128
FOX_GATE_BIAS = 3.0
DIFF_HEADS = MIX_HEADS // 2
NSA_HEADS = MIX_HEADS - DIFF_HEADS
DIFF_SUB = HEAD_DIM // 2
DIFF_W = DIFF_HEADS * HEAD_DIM
NSA_W = NSA_HEADS * HEAD_DIM
NSA_KV_HEADS = 2
NSA_GROUP = NSA_HEADS // NSA_KV_HEADS
NSA_KV_W = NSA_KV_HEADS * HEAD_DIM
CMP_LEN = 32
CMP_STRIDE = 16
SLC_LEN = 64
SLC_TOPN = 16
WINDOW = 512
SEL_BIG = 1e9
T5_BUCKETS = 32
T5_MAX_DIST = 128
T5_HEADS = DIFF_HEADS + NSA_HEADS
D_FF = -(-(8 * D_MODEL) // (3 * 256)) * 256
PLE_DIM = 256
N_EVEN = (DEPTH + 1) // 2
N_ODD = DEPTH // 2
EVEN_SPLITS = (RET_W, RET_W, RET_W, RET_W, FOX_W, FOX_W, FOX_W, FOX_HEADS)
ODD_SPLITS = (DIFF_W, DIFF_W, DIFF_W, NSA_W, NSA_KV_W, NSA_KV_W, NSA_KV_W, NSA_KV_W, NSA_KV_W, NSA_KV_W, 3 * NSA_HEADS)
EVEN_COLS = sum(EVEN_SPLITS)
ODD_COLS = sum(ODD_SPLITS)

kernel_name = 'hybrid_retention_fox_diff_nsa_trunk'


def rmsnorm(x, g):
    xf = x.astype(jnp.float32)
    y = xf * lax.rsqrt(jnp.mean(jnp.square(xf), -1, keepdims=True) + NORM_EPS) * g.astype(jnp.float32)
    return y.astype(x.dtype)


def split_cols(z, sizes):
    return jnp.split(z, [int(v) for v in np.cumsum(sizes)[:-1]], axis=-1)


def heads(a, n):
    B, S, _ = a.shape
    return a.reshape(B, S, n, -1).transpose(0, 2, 1, 3)


def merge(a):
    B, n, S, d = a.shape
    return a.transpose(0, 2, 1, 3).reshape(B, S, n * d)


def to_blocks(a, axis):
    shp = a.shape
    a = a.reshape(shp[:axis] + (shp[axis] // QBLOCK, QBLOCK) + shp[axis + 1:])
    return jnp.moveaxis(a, axis, 0)


def from_blocks(a, axis):
    a = jnp.moveaxis(a, 0, axis)
    shp = a.shape
    return a.reshape(shp[:axis] + (shp[axis] * shp[axis + 1],) + shp[axis + 2:])


def masked_softmax(logits, mask):
    logits = jnp.where(mask, logits.astype(jnp.float32), -jnp.inf)
    m = jnp.max(logits, -1, keepdims=True)
    m = jnp.where(jnp.isfinite(m), m, 0.0)
    e = jnp.where(mask, jnp.exp(logits - m), 0.0)
    return e / jnp.maximum(jnp.sum(e, -1, keepdims=True), 1e-30)


def t5_bucket(dist):
    n = jnp.maximum(dist, 0)
    max_exact = T5_BUCKETS // 2
    nf = jnp.maximum(n, 1).astype(jnp.float32)
    large = max_exact + (jnp.log(nf / max_exact) / math.log(T5_MAX_DIST / max_exact) * (T5_BUCKETS - max_exact)).astype(jnp.int32)
    large = jnp.minimum(large, T5_BUCKETS - 1)
    return jnp.where(n < max_exact, n, large)


def retention(q, k, v):
    B, H, S, d = q.shape
    C = RET_CHUNK
    N = S // C
    log_gamma = jnp.log1p(-jnp.exp2(-5.0 - jnp.arange(H, dtype=jnp.float32)))
    pos = jnp.arange(C, dtype=jnp.float32)
    rel = pos[:, None] - pos[None, :]
    intra_decay = jnp.where(rel >= 0, jnp.exp(log_gamma[:, None, None] * jnp.maximum(rel, 0.0)), 0.0)
    qc = q.reshape(B, H, N, C, d)
    kc = (k * d ** -0.5).reshape(B, H, N, C, d)
    vc = v.reshape(B, H, N, C, d)
    att = jnp.einsum('bhncd,bhnsd->bhncs', qc, kc) * intra_decay[None, :, None]
    y_intra = jnp.einsum('bhncs,bhnse->bhnce', att, vc)
    k_w = jnp.exp(log_gamma[:, None] * (C - 1 - pos))
    upd = jnp.einsum('bhnsd,bhnse->bhnde', kc * k_w[None, :, None, :, None], vc)
    chunk_decay = jnp.exp(log_gamma * C)[None, :, None, None]

    def step(state, u):
        return state * chunk_decay + u, state

    _, prev = lax.scan(step, jnp.zeros((B, H, d, d), jnp.float32), jnp.moveaxis(upd, 2, 0))
    prev = jnp.moveaxis(prev, 0, 2)
    q_w = jnp.exp(log_gamma[:, None] * (pos + 1.0))
    y_cross = jnp.einsum('bhncd,bhnde->bhnce', qc * q_w[None, :, None, :, None], prev)
    return (y_intra + y_cross).reshape(B, H, S, d)


def forgetting_attention(q, k, v, log_f):
    B, H, S, d = q.shape
    NB = S // QBLOCK
    c = jnp.cumsum(log_f, axis=-1)
    kpos = jnp.arange(S)
    scale = d ** -0.5

    def blk(args):
        qb, cb, i = args
        t = i * QBLOCK + jnp.arange(QBLOCK)
        logits = jnp.einsum('bhqd,bhsd->bhqs', qb, k).astype(jnp.float32) * scale + cb[..., None] - c[:, :, None, :]
        pr = masked_softmax(logits, kpos[None, :] <= t[:, None])
        return jnp.einsum('bhqs,bhsd->bhqd', pr.astype(v.dtype), v)

    out = lax.map(blk, (to_blocks(q, 2), to_blocks(c, 2), jnp.arange(NB)))
    return from_blocks(out, 2)


def diff_attention(q, k, v, lam, subln_g, lambda_init, t5_diff):
    B, H, S, _, e = q.shape
    NB = S // QBLOCK
    kpos = jnp.arange(S)
    lam_f = lam.astype(jnp.float32)
    lmbda = jnp.exp(jnp.sum(lam_f[0] * lam_f[1])) - jnp.exp(jnp.sum(lam_f[2] * lam_f[3])) + lambda_init
    table = t5_diff.astype(jnp.float32)
    scale = e ** -0.5

    def blk(args):
        qb, i = args
        t = i * QBLOCK + jnp.arange(QBLOCK)
        bias = jnp.transpose(table[t5_bucket(t[:, None] - kpos[None, :])], (2, 0, 1))
        logits = jnp.einsum('bhqme,bhsme->bhmqs', qb, k).astype(jnp.float32) * scale + bias[None, :, None]
        pr = masked_softmax(logits, kpos[None, :] <= t[:, None])
        w = pr[:, :, 0] - lmbda * pr[:, :, 1]
        return jnp.einsum('bhqs,bhsd->bhqd', w.astype(v.dtype), v)

    o = from_blocks(lax.map(blk, (to_blocks(q, 2), jnp.arange(NB))), 2)
    return (rmsnorm(o, subln_g).astype(jnp.float32) * (1.0 - lambda_init)).astype(v.dtype)


def compress_tokens(kv, pos_emb, w1, w2):
    B, G, S, d = kv.shape
    NC = (S - CMP_LEN) // CMP_STRIDE + 1
    gidx = jnp.arange(NC)[:, None] * CMP_STRIDE + jnp.arange(CMP_LEN)[None, :]
    blocks = kv[:, :, gidx] + pos_emb
    hid = jax.nn.silu(blocks.reshape(B, G, NC, CMP_LEN * d) @ w1)
    return hid @ w2


def nsa_attention(q, kc, vc, ks, vs, kw, vw, gates, t5_nsa):
    B, G, R, S, d = q.shape
    NB = S // QBLOCK
    NC = kc.shape[2]
    NS = S // SLC_LEN
    n_sel = min(SLC_TOPN, NS)
    scale = d ** -0.5
    tbl = t5_nsa.astype(jnp.float32).reshape(T5_BUCKETS, G, R)
    tbl_g = jnp.transpose(tbl, (1, 0, 2))
    cmp_end = jnp.arange(NC) * CMP_STRIDE + CMP_LEN - 1
    blk_start = jnp.arange(NS) * SLC_LEN
    overlap = ((cmp_end[:, None] - CMP_LEN + 1 <= blk_start[None, :] + SLC_LEN - 1) & (cmp_end[:, None] >= blk_start[None, :])).astype(jnp.float32)
    ks_b = ks.reshape(B, G, NS, SLC_LEN, d)
    vs_b = vs.reshape(B, G, NS, SLC_LEN, d)
    kw_pad = jnp.pad(kw, ((0, 0), (0, 0), (WINDOW, 0), (0, 0)))
    vw_pad = jnp.pad(vw, ((0, 0), (0, 0), (WINDOW, 0), (0, 0)))
    b_ix = jnp.arange(B)[:, None, None, None]
    g_ix = jnp.arange(G)[None, :, None, None]
    in_blk = jnp.arange(SLC_LEN)
    win_off = jnp.arange(QBLOCK + WINDOW) - WINDOW
    sel_ids = jnp.arange(NS)[None, :]

    def head_bias(bucket):
        return jnp.transpose(tbl[bucket], (2, 3, 0, 1))

    def blk(args):
        qb, gb, i = args
        q0 = i * QBLOCK
        t = q0 + jnp.arange(QBLOCK)
        lc = jnp.einsum('bgrqd,bgnd->bgrqn', qb, kc).astype(jnp.float32) * scale + head_bias(t5_bucket(t[:, None] - cmp_end[None, :]))
        p_cmp = masked_softmax(lc, cmp_end[None, :] <= t[:, None])
        o_cmp = jnp.einsum('bgrqn,bgnd->bgrqd', p_cmp.astype(vc.dtype), vc)
        imp = jnp.einsum('bgrqn,ns->bgqs', p_cmp, overlap)
        cur = (t // SLC_LEN)[:, None]
        forced = (sel_ids == 0) | (sel_ids == cur) | (sel_ids == cur - 1)
        valid = blk_start[None, :] <= t[:, None]
        score = jnp.where(forced, SEL_BIG, jnp.where(valid, imp, -SEL_BIG))
        _, idx = lax.top_k(score, n_sel)
        k_sel = ks_b[b_ix, g_ix, idx].reshape(B, G, QBLOCK, n_sel * SLC_LEN, d)
        v_sel = vs_b[b_ix, g_ix, idx].reshape(B, G, QBLOCK, n_sel * SLC_LEN, d)
        pos = (idx[..., None] * SLC_LEN + in_blk).reshape(B, G, QBLOCK, n_sel * SLC_LEN)
        dist = t[None, None, :, None] - pos
        bias_s = jnp.moveaxis(tbl_g[g_ix, t5_bucket(dist)], -1, 2)
        ls = jnp.einsum('bgrqd,bgqld->bgrql', qb, k_sel).astype(jnp.float32) * scale + bias_s
        p_slc = masked_softmax(ls, (dist >= 0)[:, :, None])
        o_slc = jnp.einsum('bgrql,bgqld->bgrqd', p_slc.astype(v_sel.dtype), v_sel)
        kwin = lax.dynamic_slice_in_dim(kw_pad, q0, QBLOCK + WINDOW, axis=2)
        vwin = lax.dynamic_slice_in_dim(vw_pad, q0, QBLOCK + WINDOW, axis=2)
        s = q0 + win_off
        dw = t[:, None] - s[None, :]
        mw = (dw >= 0) & (dw < WINDOW) & (s[None, :] >= 0)
        lw = jnp.einsum('bgrqd,bgkd->bgrqk', qb, kwin).astype(jnp.float32) * scale + head_bias(t5_bucket(dw))
        p_win = masked_softmax(lw, mw)
        o_win = jnp.einsum('bgrqk,bgkd->bgrqd', p_win.astype(vwin.dtype), vwin)
        g = jnp.transpose(gb.reshape(B, QBLOCK, 3, G, R), (2, 0, 3, 4, 1))[..., None]
        return g[0] * o_cmp + g[1] * o_slc + g[2] * o_win

    out = lax.map(blk, (to_blocks(q, 3), to_blocks(gates, 1), jnp.arange(NB)))
    return from_blocks(out, 3)


def even_mixer(h, w_in, ret_gn, fox_fb, w_out):
    z = h @ w_in
    rq, rk, rv, rg, fq, fk, fv, fl = split_cols(z, EVEN_SPLITS)
    f32 = jnp.float32
    y = retention(heads(rq, RET_HEADS).astype(f32), heads(rk, RET_HEADS).astype(f32), heads(rv, RET_HEADS).astype(f32))
    mu = jnp.mean(y, -1, keepdims=True)
    var = jnp.mean(jnp.square(y - mu), -1, keepdims=True)
    y = merge((y - mu) * lax.rsqrt(var + NORM_EPS)) * ret_gn.astype(f32)
    ret_out = (y * jax.nn.silu(rg.astype(f32))).astype(h.dtype)
    log_f = jax.nn.log_sigmoid(fl.astype(f32) + fox_fb.astype(f32)).transpose(0, 2, 1)
    fox_out = merge(forgetting_attention(heads(fq, FOX_HEADS), heads(fk, FOX_HEADS), heads(fv, FOX_HEADS), log_f))
    return jnp.concatenate([ret_out, fox_out.astype(h.dtype)], -1) @ w_out


def odd_mixer(h, w_in, diff_lambda, diff_subln, cmp_pos, cmp_w1, cmp_w2, w_out, t5_table, lambda_init):
    B, S, _ = h.shape
    z = h @ w_in
    dq, dk, dv, nq, ck, cv, sk, sv, wk, wv, gl = split_cols(z, ODD_SPLITS)
    dq = dq.reshape(B, S, DIFF_HEADS, 2, DIFF_SUB).transpose(0, 2, 1, 3, 4)
    dk = dk.reshape(B, S, DIFF_HEADS, 2, DIFF_SUB).transpose(0, 2, 1, 3, 4)
    diff_out = merge(diff_attention(dq, dk, heads(dv, DIFF_HEADS), diff_lambda, diff_subln, lambda_init, t5_table[:, :DIFF_HEADS]))
    nq = nq.reshape(B, S, NSA_KV_HEADS, NSA_GROUP, HEAD_DIM).transpose(0, 2, 3, 1, 4)
    kc = compress_tokens(heads(ck, NSA_KV_HEADS), cmp_pos[0], cmp_w1[0], cmp_w2[0])
    vc = compress_tokens(heads(cv, NSA_KV_HEADS), cmp_pos[1], cmp_w1[1], cmp_w2[1])
    gates = jax.nn.sigmoid(gl).reshape(B, S, 3, NSA_HEADS)
    o = nsa_attention(nq, kc, vc, heads(sk, NSA_KV_HEADS), heads(sv, NSA_KV_HEADS), heads(wk, NSA_KV_HEADS), heads(wv, NSA_KV_HEADS), gates, t5_table[:, DIFF_HEADS:])
    nsa_out = o.transpose(0, 3, 1, 2, 4).reshape(B, S, NSA_W)
    return jnp.concatenate([diff_out.astype(h.dtype), nsa_out.astype(h.dtype)], -1) @ w_out


def setup_inputs(seed: int = 0) -> dict:
    key = jax.random.key(seed)
    ks = jax.random.split(key, 24)
    f32 = jnp.float32

    def nrm(k, shape, scale):
        return jax.random.normal(k, shape, f32) * scale

    return {
        'x': nrm(ks[0], (BATCH, SEQ, D_MODEL), 1.0),
        'p': nrm(ks[1], (DEPTH, BATCH, SEQ, PLE_DIM), 1.0),
        'norm_mix': 1.0 + nrm(ks[2], (DEPTH, D_MODEL), 0.02),
        'norm_ffn': 1.0 + nrm(ks[3], (DEPTH, D_MODEL), 0.02),
        'w_in_even': nrm(ks[4], (N_EVEN, D_MODEL, EVEN_COLS), D_MODEL ** -0.5),
        'ret_gn': 1.0 + nrm(ks[5], (N_EVEN, RET_W), 0.02),
        'fox_fb': FOX_GATE_BIAS + nrm(ks[6], (N_EVEN, FOX_HEADS), 0.5),
        'w_out_even': nrm(ks[7], (N_EVEN, MIX_W, D_MODEL), MIX_W ** -0.5),
        'w_in_odd': nrm(ks[8], (N_ODD, D_MODEL, ODD_COLS), D_MODEL ** -0.5),
        'diff_lambda': nrm(ks[9], (N_ODD, 4, DIFF_SUB), 0.1),
        'diff_subln': 1.0 + nrm(ks[10], (N_ODD, HEAD_DIM), 0.02),
        'cmp_pos': nrm(ks[11], (N_ODD, 2, CMP_LEN, HEAD_DIM), 0.02),
        'cmp_w1': nrm(ks[12], (N_ODD, 2, CMP_LEN * HEAD_DIM, HEAD_DIM), (CMP_LEN * HEAD_DIM) ** -0.5),
        'cmp_w2': nrm(ks[13], (N_ODD, 2, HEAD_DIM, HEAD_DIM), HEAD_DIM ** -0.5),
        'w_out_odd': nrm(ks[14], (N_ODD, MIX_W, D_MODEL), MIX_W ** -0.5),
        't5_table': nrm(ks[15], (T5_BUCKETS, T5_HEADS), 0.2),
        'ffn_gate': nrm(ks[16], (DEPTH, D_MODEL, D_FF), D_MODEL ** -0.5),
        'ffn_up': nrm(ks[17], (DEPTH, D_MODEL, D_FF), D_MODEL ** -0.5),
        'ffn_down': nrm(ks[18], (DEPTH, D_FF, D_MODEL), D_FF ** -0.5),
        'ple_gate': nrm(ks[19], (DEPTH, D_MODEL, D_MODEL), D_MODEL ** -0.5),
        'ple_proj': nrm(ks[20], (DEPTH, PLE_DIM, D_MODEL), PLE_DIM ** -0.5),
        'final_norm': 1.0 + nrm(ks[21], (D_MODEL,), 0.02),
    }


def reference(x, p, norm_mix, norm_ffn, w_in_even, ret_gn, fox_fb, w_out_even, w_in_odd, diff_lambda, diff_subln, cmp_pos, cmp_w1, cmp_w2, w_out_odd, t5_table, ffn_gate, ffn_up, ffn_down, ple_gate, ple_proj, final_norm):
    for i in range(DEPTH):
        j = i // 2
        h = rmsnorm(x, norm_mix[i])
        if i % 2 == 0:
            mix = even_mixer(h, w_in_even[j], ret_gn[j], fox_fb[j], w_out_even[j])
        else:
            lambda_init = 0.8 - 0.6 * math.exp(-0.3 * i)
            mix = odd_mixer(h, w_in_odd[j], diff_lambda[j], diff_subln[j], cmp_pos[j], cmp_w1[j], cmp_w2[j], w_out_odd[j], t5_table, lambda_init)
        x = x + mix
        h = rmsnorm(x, norm_ffn[i])
        x = x + (jax.nn.silu(h @ ffn_gate[i]) * (h @ ffn_up[i])) @ ffn_down[i]
        x = x + jax.nn.sigmoid(x @ ple_gate[i]) * (p[i] @ ple_proj[i])
    return rmsnorm(x, final_norm)
```

```cpp
#include <hip/hip_runtime.h>
#include <hip/hip_cooperative_groups.h>
#include <stdint.h>
#include <cstdio>
namespace cg = cooperative_groups;

#define LAS __attribute__((address_space(3)))
typedef unsigned short bfraw;
typedef short bf16x8 __attribute__((ext_vector_type(8)));
typedef float f32x4 __attribute__((ext_vector_type(4)));
typedef float f32x16 __attribute__((ext_vector_type(16)));
typedef unsigned u32x4 __attribute__((ext_vector_type(4)));
typedef unsigned u32x2 __attribute__((ext_vector_type(2)));

constexpr int S = 16384, DM = 2048, DFF = 5632, PLE = 256;
constexpr int EVEN_COLS = 7176, ODD_COLS = 5656;
constexpr float EPS = 1e-6f;
constexpr float LOG2E = 1.4426950408889634f;
constexpr float NEG = -1e30f;
constexpr float LINIT = 0.35550906759096934f;
constexpr int NTHREADS = 512;
constexpr int LDS_BYTES = 147456;

constexpr size_t WS_W = 0;
constexpr size_t W_IN = 0, W_OUT = 15204352, W_GU = 19398656, W_D = 42467328, W_PG = 54001664, W_PP = 58195968, W_C1 = 58720256, W_C2 = 59768832, W_END = 59801600;
constexpr size_t WS_XB = WS_W + W_END * 2;
constexpr size_t WS_Z = WS_XB + (size_t)S * DM * 2;
constexpr size_t WS_M = WS_Z + (size_t)S * 7168 * 2;
constexpr size_t WS_PB = WS_M + (size_t)S * DM * 2;
constexpr size_t WS_SSQ = WS_PB + (size_t)2 * S * PLE * 2;
constexpr size_t WS_FL = WS_SSQ + (size_t)S * 32 * 4;
constexpr size_t WS_C2 = WS_FL + (size_t)8 * S * 4;
constexpr size_t WS_GATES = WS_C2 + (size_t)8 * S * 4;
constexpr size_t WS_SEL = WS_GATES + (size_t)S * 24 * 4;
constexpr size_t WS_KC = WS_SEL + (size_t)S * 16 * 4;
constexpr size_t WS_VCT = WS_KC + (size_t)2 * 1024 * 128 * 2;
constexpr size_t WS_PBIAS = WS_VCT + (size_t)2 * 1024 * 128 * 2;
constexpr size_t WS_KMAX = WS_PBIAS + 2048;
constexpr size_t WS_BAR = WS_PBIAS + 4096;
constexpr size_t WS_RINV = WS_PBIAS + 8192;
constexpr size_t WS_END = WS_RINV + (size_t)S * 4;
constexpr size_t Z0_RQK = 0, Z0_RG = (size_t)2048 * S, Z0_FQK = (size_t)3072 * S, Z0_VT = (size_t)5120 * S;
constexpr size_t CKV_HS = (size_t)(S + 32) * 128;
constexpr size_t Z1_DQK = 0, Z1_NQ = (size_t)2048 * S, Z1_CK = (size_t)3072 * S, Z1_CV = Z1_CK + 2 * CKV_HS, Z1_SK = Z1_CV + 2 * CKV_HS,
                 Z1_WK = Z1_SK + (size_t)256 * S, Z1_VT = Z1_WK + (size_t)256 * S;

struct Params {
    const float* in[22];
    float* out;
    unsigned char* ws;
    int ph_lo, ph_hi;
};

typedef const __attribute__((address_space(4))) Params& CPR;
__device__ __forceinline__ int otid() { int t = threadIdx.x; asm volatile("" : "+v"(t)); return t; }
__device__ __forceinline__ unsigned short f2bf(float f) { unsigned u = __float_as_uint(f); u += 0x7fffu + ((u >> 16) & 1u); return (unsigned short)(u >> 16); }
__device__ __forceinline__ float bf2f(unsigned short b) { return __uint_as_float(((unsigned)b) << 16); }
__device__ __forceinline__ unsigned pack2(float lo, float hi) { unsigned r; asm volatile("v_cvt_pk_bf16_f32 %0, %1, %2" : "=v"(r) : "v"(lo), "v"(hi)); return r; }
__device__ __forceinline__ float fexp2(float x) { return __builtin_amdgcn_exp2f(x); }
template <int CTRL> __device__ __forceinline__ int dppi(int v) { return __builtin_amdgcn_update_dpp(v, v, CTRL, 0xF, 0xF, false); }
template <int CTRL> __device__ __forceinline__ float dppf(float v) { return __int_as_float(dppi<CTRL>(__float_as_int(v))); }
__device__ __forceinline__ void amax_merge(float& bv, int& bj, float ov, int oj) { if (ov > bv || (ov == bv && oj < bj)) { bv = ov; bj = oj; } }
__device__ __forceinline__ void wave_argmax(float& bv, int& bj) {
    typedef unsigned u2v __attribute__((ext_vector_type(2)));
    amax_merge(bv, bj, dppf<0xB1>(bv), dppi<0xB1>(bj));
    amax_merge(bv, bj, dppf<0x4E>(bv), dppi<0x4E>(bj));
    amax_merge(bv, bj, dppf<0x141>(bv), dppi<0x141>(bj));
    amax_merge(bv, bj, dppf<0x140>(bv), dppi<0x140>(bj));
    {
        const u2v rv = __builtin_amdgcn_permlane16_swap(__float_as_uint(bv), __float_as_uint(bv), false, false);
        const u2v rj = __builtin_amdgcn_permlane16_swap((unsigned)bj, (unsigned)bj, false, false);
        float av = __uint_as_float(rv[0]); int aj = (int)rj[0];
        amax_merge(av, aj, __uint_as_float(rv[1]), (int)rj[1]); bv = av; bj = aj;
    }
    {
        const u2v rv = __builtin_amdgcn_permlane32_swap(__float_as_uint(bv), __float_as_uint(bv), false, false);
        const u2v rj = __builtin_amdgcn_permlane32_swap((unsigned)bj, (unsigned)bj, false, false);
        float av = __uint_as_float(rv[0]); int aj = (int)rj[0];
        amax_merge(av, aj, __uint_as_float(rv[1]), (int)rj[1]); bv = av; bj = aj;
    }
}
__device__ __forceinline__ float wsum(float v) {
    typedef unsigned u2v __attribute__((ext_vector_type(2)));
    v += dppf<0xB1>(v); v += dppf<0x4E>(v); v += dppf<0x141>(v); v += dppf<0x140>(v);
    { const u2v r = __builtin_amdgcn_permlane16_swap(__float_as_uint(v), __float_as_uint(v), false, false); v = __uint_as_float(r[0]) + __uint_as_float(r[1]); }
    { const u2v r = __builtin_amdgcn_permlane32_swap(__float_as_uint(v), __float_as_uint(v), false, false); v = __uint_as_float(r[0]) + __uint_as_float(r[1]); }
    return v;
}
__device__ __forceinline__ float xhalf_max(float x) {
    typedef unsigned u2v __attribute__((ext_vector_type(2)));
    const u2v r = __builtin_amdgcn_permlane32_swap(__float_as_uint(x), __float_as_uint(x), false, false);
    return fmaxf(__uint_as_float(r[0]), __uint_as_float(r[1]));
}
__device__ __forceinline__ float fmax3(float a, float b, float c) { float d; asm("v_max3_f32 %0, %1, %2, %3" : "=v"(d) : "v"(a), "v"(b), "v"(c)); return d; }
__device__ __forceinline__ float sigmoidf_(float x) { return __builtin_amdgcn_rcpf(1.0f + fexp2(-LOG2E * x)); }
__device__ __forceinline__ float siluf_(float x) { return x * __builtin_amdgcn_rcpf(1.0f + fexp2(-LOG2E * x)); }
__device__ __forceinline__ float row_rinv(const float* ssq, int row) {
    const f32x4* p = (const f32x4*)(ssq + (size_t)row * 32);
    float s = 0.f;
#pragma unroll
    for (int i = 0; i < 8; ++i) { f32x4 v = p[i]; s += (v[0] + v[1]) + (v[2] + v[3]); }
    return rsqrtf(s * (1.0f / 2048.0f) + EPS);
}

namespace pg8 {
constexpr int BM = 256, BK = 64, HALF = 128, HTB = HALF * BK * 2, STAGE_BYTES = 8 * HTB, NXCD = 8, WGM = 8;
__device__ __forceinline__ int lds_byte(int r, int c) { const int st = (r >> 4) * 2 + (c >> 5), rr = r & 15, cc = c & 31, ob = rr * 64 + cc * 2; return st * 1024 + (ob ^ (((ob >> 9) & 1) << 5)); }
__device__ __forceinline__ void stage_rc(int b, int& R, int& C) { const int st = b / 1024, sb = b % 1024, swz = sb ^ (((sb >> 9) & 1) << 5); R = (st >> 1) * 16 + swz / 64; C = (st & 1) * 32 + (swz % 64) / 2; }
struct Unit { int pm, pn, job; };
struct Gemm { const bfraw* A0; const bfraw* A1; const bfraw* Bt0; const bfraw* Bt1; int K; };
struct Sched2 {
    int nM[2], nN[2], nwg[2], G, c;
    __device__ void init(int M0, int N0, int M1, int N1, int G_, int c_) { nM[0] = M0 / BM; nN[0] = N0 / BM; nwg[0] = nM[0] * nN[0]; nM[1] = M1 / BM; nN[1] = N1 / BM; nwg[1] = nM[1] * nN[1]; G = G_; c = c_; }
    __device__ __forceinline__ void map(int wgid, int j, Unit& u) const {
        const int nwgj = nwg[j], nMj = nM[j], nNj = nN[j];
        { const int q = nwgj / NXCD, r = nwgj % NXCD, xcd = wgid % NXCD, off = wgid / NXCD; wgid = (xcd < r ? xcd * (q + 1) : r * (q + 1) + (xcd - r) * q) + off; }
        const int nig = WGM * nNj, gid = wgid / nig, fm = gid * WGM, gsz = (nMj - fm) < WGM ? (nMj - fm) : WGM;
        u.pm = fm + ((wgid % nig) % gsz); u.pn = (wgid % nig) / gsz; u.job = j;
    }
    __device__ __forceinline__ bool next(int i, Unit& u) const {
        long L = (long)i * G + c;
        if (L < nwg[0]) { map((int)L, 0, u); return true; }
        L -= nwg[0];
        if (L < nwg[1]) { map((int)L, 1, u); return true; }
        return false;
    }
};

template <class Epi>
__device__ __forceinline__ void gemm_phase(LAS unsigned char* lds, const Gemm g, const Sched2& S_, const Epi& E) {
    const int tid = otid(), wid = __builtin_amdgcn_readfirstlane(tid >> 6), lane = tid & 63, wr = wid >> 2, wc = wid & 3, fr = lane & 15, fq = lane >> 4;
    const int K = g.K, nt = K / BK;
    unsigned voffA[2], voffB[2];
#pragma unroll
    for (int i = 0; i < 2; ++i) { int R, C; stage_rc(tid * 16 + i * 8192, R, C); voffA[i] = (unsigned)(R * K + C) * 2u; voffB[i] = voffA[i]; }
    const size_t kstep = (size_t)(BK * 2);
    const size_t hstep = (size_t)HALF * K * 2;
    const size_t tstep = 2 * hstep;
    const unsigned ldsw = (unsigned)wid * 1024u;
    const int aoff = lds_byte(wr * 64 + fr, fq * 8), boff = lds_byte(wc * 32 + fr, fq * 8);
#define PG8_SA(b, h) (((b) * 2 + (h)) * HTB)
#define PG8_SB(b, h) ((4 + (b) * 2 + (h)) * HTB)
#define PG8_STAGE(bufoff, gbase, voff) do { _Pragma("unroll") for (int _i = 0; _i < 2; ++_i) \
        __builtin_amdgcn_global_load_lds((const unsigned*)((const char*)(gbase) + (voff)[_i]), (LAS unsigned*)(lds + (bufoff) + ldsw + _i * 8192), 16, 0, 0); } while (0)
#define PG8_LDA(dst, b, h) do { _Pragma("unroll") for (int m = 0; m < 4; ++m) _Pragma("unroll") for (int k = 0; k < 2; ++k) dst[m][k] = *(const LAS bf16x8*)(lds + PG8_SA(b, h) + aoff + m * 2048 + k * 1024); } while (0)
#define PG8_LDB(dst, b, h) do { _Pragma("unroll") for (int n = 0; n < 2; ++n) _Pragma("unroll") for (int k = 0; k < 2; ++k) dst[n][k] = *(const LAS bf16x8*)(lds + PG8_SB(b, h) + boff + n * 2048 + k * 1024); } while (0)
#define PG8_MMA(ai, bj, At, Bt) do { __builtin_amdgcn_s_setprio(1); _Pragma("unroll") for (int m = 0; m < 4; ++m) _Pragma("unroll") for (int n = 0; n < 2; ++n) _Pragma("unroll") for (int k = 0; k < 2; ++k) \
        acc[ai][bj][m][n] = __builtin_amdgcn_mfma_f32_16x16x32_bf16(Bt[n][k], At[m][k], acc[ai][bj][m][n], 0, 0, 0); __builtin_amdgcn_s_setprio(0); } while (0)
#define PG8_WAIT_V(n) asm volatile("s_waitcnt vmcnt(" #n ")" ::: "memory")
#define PG8_WAIT_L(n) asm volatile("s_waitcnt lgkmcnt(" #n ")" ::: "memory")
#define PG8_BAR __builtin_amdgcn_s_barrier()
#define PG8_SCHED __builtin_amdgcn_sched_barrier(0)
    Unit cur, nxt; int ui = 0;
    if (!S_.next(0, cur)) return;
    f32x4 acc[2][2][4][2];
#pragma unroll
    for (int a = 0; a < 2; ++a)
#pragma unroll
        for (int b = 0; b < 2; ++b)
#pragma unroll
            for (int m = 0; m < 4; ++m)
#pragma unroll
                for (int n = 0; n < 2; ++n) acc[a][b][m][n] = (f32x4){0.f, 0.f, 0.f, 0.f};
    bf16x8 At[4][2], B0[2][2], B1[2][2];
    const char* cA = (const char*)(cur.job ? g.A1 : g.A0) + (size_t)cur.pm * tstep; const char* cB = (const char*)(cur.job ? g.Bt1 : g.Bt0) + (size_t)cur.pn * tstep;
    PG8_STAGE(PG8_SB(0, 0), cB, voffB); PG8_STAGE(PG8_SA(0, 0), cA, voffA); PG8_STAGE(PG8_SB(0, 1), cB + hstep, voffB); PG8_STAGE(PG8_SA(0, 1), cA + hstep, voffA);
    if (wr == 1) PG8_BAR;
    PG8_WAIT_V(4); PG8_BAR;
    PG8_STAGE(PG8_SB(1, 0), cB + kstep, voffB); PG8_STAGE(PG8_SA(1, 0), cA + kstep, voffA); PG8_STAGE(PG8_SB(1, 1), cB + hstep + kstep, voffB);
    PG8_WAIT_V(6); PG8_BAR;
    for (;;) {
        const bool has_next = S_.next(ui + 1, nxt);
        const char* nA = has_next ? (const char*)(nxt.job ? g.A1 : g.A0) + (size_t)nxt.pm * tstep : cA; const char* nB = has_next ? (const char*)(nxt.job ? g.Bt1 : g.Bt0) + (size_t)nxt.pn * tstep : cB;
        for (int t = 0; t < nt; t += 2) {
            const bool last = (t == nt - 2);
            const char* a1 = cA + (size_t)(t + 1) * kstep;
            const char* a2 = last ? nA : cA + (size_t)(t + 2) * kstep; const char* b2 = last ? nB : cB + (size_t)(t + 2) * kstep;
            const char* a3 = a2 + kstep; const char* b3 = b2 + kstep;
            PG8_LDB(B0, 0, 0); PG8_SCHED; PG8_LDA(At, 0, 0); PG8_STAGE(PG8_SA(1, 1), a1 + hstep, voffA);
            PG8_WAIT_L(8); PG8_BAR; PG8_WAIT_L(0); PG8_MMA(0, 0, At, B0); PG8_BAR; PG8_SCHED;
            PG8_LDB(B1, 0, 1); PG8_STAGE(PG8_SB(0, 0), b2, voffB);
            PG8_BAR; PG8_WAIT_L(0); PG8_MMA(0, 1, At, B1); PG8_BAR;
            PG8_LDA(At, 0, 1); PG8_STAGE(PG8_SA(0, 0), a2, voffA);
            PG8_BAR; PG8_WAIT_L(0); PG8_MMA(1, 0, At, B0); PG8_BAR; PG8_SCHED;
            PG8_STAGE(PG8_SB(0, 1), b2 + hstep, voffB);
            PG8_WAIT_V(6); PG8_BAR; PG8_MMA(1, 1, At, B1); PG8_BAR;
            PG8_LDB(B0, 1, 0); PG8_SCHED; PG8_LDA(At, 1, 0); PG8_STAGE(PG8_SA(0, 1), a2 + hstep, voffA);
            PG8_WAIT_L(8); PG8_BAR; PG8_WAIT_L(0); PG8_MMA(0, 0, At, B0); PG8_BAR; PG8_SCHED;
            PG8_LDB(B1, 1, 1); PG8_STAGE(PG8_SB(1, 0), b3, voffB);
            PG8_BAR; PG8_WAIT_L(0); PG8_MMA(0, 1, At, B1); PG8_BAR;
            PG8_LDA(At, 1, 1); PG8_STAGE(PG8_SA(1, 0), a3, voffA);
            PG8_BAR; PG8_WAIT_L(0); PG8_MMA(1, 0, At, B0); PG8_BAR; PG8_SCHED;
            PG8_STAGE(PG8_SB(1, 1), b3 + hstep, voffB);
            PG8_WAIT_V(6); PG8_BAR; PG8_MMA(1, 1, At, B1); PG8_BAR;
        }
        E(acc, cur, wr, wc, fr, fq);
        if (!has_next) break;
#pragma unroll
        for (int a = 0; a < 2; ++a)
#pragma unroll
            for (int b = 0; b < 2; ++b)
#pragma unroll
                for (int m = 0; m < 4; ++m)
#pragma unroll
                    for (int n = 0; n < 2; ++n) acc[a][b][m][n] = (f32x4){0.f, 0.f, 0.f, 0.f};
        cur = nxt; cA = nA; cB = nB; ++ui;
    }
    PG8_WAIT_V(0);
    if (wr == 0) PG8_BAR;
    PG8_BAR;
#undef PG8_SA
#undef PG8_SB
#undef PG8_STAGE
#undef PG8_LDA
#undef PG8_LDB
#undef PG8_MMA
#undef PG8_WAIT_V
#undef PG8_WAIT_L
#undef PG8_BAR
#undef PG8_SCHED
}
}
using pg8::Unit;
typedef f32x4 AccT[2][2][4][2];

__device__ __forceinline__ void st_bf4(bfraw* p, f32x4 v) { u32x2 o; o[0] = pack2(v[0], v[1]); o[1] = pack2(v[2], v[3]); *(u32x2*)p = o; }

struct EpiZ {
    const float* ssq; bfraw* z; float* aux; int layer;
    __device__ __forceinline__ void operator()(const AccT& acc, const Unit& u, int wr, int wc, int fr, int fq) const {
        if (u.job == 0) {
            size_t base; int c0, gc; size_t hs; int kind = 0;
            const int pn = u.pn;
            if (layer == 0) {
                if (pn < 8) { base = Z0_RQK; c0 = 0; gc = 128; hs = (size_t)S * 128; }
                else if (pn < 12) { base = Z0_RG; c0 = 2048; gc = 1024; hs = 0; }
                else if (pn < 20) { base = Z0_FQK; c0 = 3072; gc = 128; hs = (size_t)S * 128; }
                else { base = 0; c0 = 5120; gc = 1; hs = 0; kind = 1; }
            } else {
                if (pn < 8) { base = Z1_DQK; c0 = 0; gc = 64; hs = (size_t)S * 64; }
                else if (pn < 12) { base = Z1_NQ; c0 = 2048; gc = 128; hs = (size_t)S * 128; }
                else if (pn == 12) { base = Z1_CK; c0 = 3072; gc = 128; hs = CKV_HS; }
                else if (pn == 13) { base = Z1_CV; c0 = 3328; gc = 128; hs = CKV_HS; }
                else if (pn == 14) { base = Z1_SK; c0 = 3584; gc = 128; hs = (size_t)S * 128; }
                else if (pn == 15) { base = Z1_WK; c0 = 3840; gc = 128; hs = (size_t)S * 128; }
                else { base = 0; c0 = 4096; gc = 1; hs = 0; kind = 2; }
            }
            const int gsh = 31 - __builtin_clz((unsigned)gc);
#pragma unroll
            for (int ai = 0; ai < 2; ++ai) {
                float ri4[4];
#pragma unroll
                for (int m = 0; m < 4; ++m) ri4[m] = ssq[u.pm * 256 + ai * 128 + wr * 64 + m * 16 + fr];
#pragma unroll
                for (int m = 0; m < 4; ++m) {
                    const int row = u.pm * 256 + ai * 128 + wr * 64 + m * 16 + fr;
                    const float ri = ri4[m];
#pragma unroll
                    for (int bj = 0; bj < 2; ++bj)
#pragma unroll
                        for (int n = 0; n < 2; ++n) {
                            const int col = pn * 256 + bj * 128 + wc * 32 + n * 16 + fq * 4;
                            f32x4 v = acc[ai][bj][m][n] * ri;
                            const int cl = col - c0;
                            if (kind == 0) {
                                st_bf4(z + base + (size_t)(cl >> gsh) * hs + ((size_t)row << gsh) + (cl & (gc - 1)), v);
                            } else if (kind == 1) {
                                if (cl < 8) {
#pragma unroll
                                    for (int j = 0; j < 4; ++j) aux[(size_t)(cl + j) * S + row] = v[j];
                                }
                            } else {
                                if (cl < 24) {
#pragma unroll
                                    for (int j = 0; j < 4; ++j) aux[(size_t)row * 24 + cl + j] = sigmoidf_(v[j]);
                                }
                            }
                        }
                }
            }
        } else {
            bfraw* vt = z + (layer == 0 ? Z0_VT : Z1_VT);
            f32x4 rq4[4];
#pragma unroll
            for (int q = 0; q < 4; ++q) rq4[q] = *(const f32x4*)(ssq + u.pn * 256 + (q >> 1) * 128 + wc * 32 + (q & 1) * 16 + fq * 4);
#pragma unroll
            for (int bj = 0; bj < 2; ++bj)
#pragma unroll
                for (int n = 0; n < 2; ++n) {
                    const int col = u.pn * 256 + bj * 128 + wc * 32 + n * 16 + fq * 4;
                    const f32x4 ri = rq4[bj * 2 + n];
#pragma unroll
                    for (int ai = 0; ai < 2; ++ai)
#pragma unroll
                        for (int m = 0; m < 4; ++m) {
                            const int row = u.pm * 256 + ai * 128 + wr * 64 + m * 16 + fr;
                            st_bf4(vt + (size_t)row * S + col, acc[ai][bj][m][n] * ri);
                        }
                }
        }
    }
};

struct EpiRes {
    const float* xin; float* xout; bfraw* xb; float* ssq; int want_ssq;
    __device__ __forceinline__ void operator()(const AccT& acc, const Unit& u, int wr, int wc, int fr, int fq) const {
        const int row_b = u.pm * 256 + wr * 64 + fr, col_b = u.pn * 256 + wc * 32 + fq * 4;
        f32x4 xv[2][4];
#pragma unroll
        for (int q = 0; q < 4; ++q) xv[0][q] = *(const f32x4*)(xin + (size_t)row_b * DM + col_b + (q >> 1) * 128 + (q & 1) * 16);
#pragma unroll
        for (int bt = 0; bt < 8; ++bt) {
            const int ai = bt >> 2, m = bt & 3;
            const int row = row_b + ai * 128 + m * 16;
            if (bt + 1 < 8) {
                const int rown = row_b + ((bt + 1) >> 2) * 128 + ((bt + 1) & 3) * 16;
#pragma unroll
                for (int q = 0; q < 4; ++q) xv[(bt + 1) & 1][q] = *(const f32x4*)(xin + (size_t)rown * DM + col_b + (q >> 1) * 128 + (q & 1) * 16);
            }
            float part = 0.f;
#pragma unroll
            for (int q = 0; q < 4; ++q) {
                const int bj = q >> 1, n = q & 1;
                const size_t o = (size_t)row * DM + col_b + bj * 128 + n * 16;
                f32x4 v = xv[bt & 1][q] + acc[ai][bj][m][n];
                *(f32x4*)(xout + o) = v;
                st_bf4(xb + o, v);
                part += (v[0] * v[0] + v[1] * v[1]) + (v[2] * v[2] + v[3] * v[3]);
            }
            if (want_ssq) {
                part += __shfl_xor(part, 16); part += __shfl_xor(part, 32);
                if (fq == 0) ssq[(size_t)row * 32 + u.pn * 4 + wc] = part;
            }
        }
    }
};
struct EpiGU {
    const float* ssq; bfraw* act;
    __device__ __forceinline__ void operator()(const AccT& acc, const Unit& u, int wr, int wc, int fr, int fq) const {
#pragma unroll
        for (int ai = 0; ai < 2; ++ai) {
            float ri4[4];
#pragma unroll
            for (int m = 0; m < 4; ++m) ri4[m] = ssq[u.pm * 256 + ai * 128 + wr * 64 + m * 16 + fr];
#pragma unroll
            for (int m = 0; m < 4; ++m) {
                const int row = u.pm * 256 + ai * 128 + wr * 64 + m * 16 + fr;
                const float ri = ri4[m];
#pragma unroll
                for (int n = 0; n < 2; ++n) {
                    const int col = u.pn * 128 + wc * 32 + n * 16 + fq * 4;
                    f32x4 gt = acc[ai][0][m][n] * ri, up = acc[ai][1][m][n] * ri, r;
#pragma unroll
                    for (int j = 0; j < 4; ++j) r[j] = siluf_(gt[j]) * up[j];
                    st_bf4(act + (size_t)row * DFF + col, r);
                }
            }
        }
    }
};
struct EpiPP {
    bfraw* pp;
    __device__ __forceinline__ void operator()(const AccT& acc, const Unit& u, int wr, int wc, int fr, int fq) const {
#pragma unroll
        for (int ai = 0; ai < 2; ++ai)
#pragma unroll
            for (int m = 0; m < 4; ++m) {
                const int row = u.pm * 256 + ai * 128 + wr * 64 + m * 16 + fr;
#pragma unroll
                for (int bj = 0; bj < 2; ++bj)
#pragma unroll
                    for (int n = 0; n < 2; ++n) {
                        const int col = u.pn * 256 + bj * 128 + wc * 32 + n * 16 + fq * 4;
                        {
                            const f32x4 v = acc[ai][bj][m][n]; u32x2 o;
                            o[0] = (unsigned)f2bf(v[0]) | ((unsigned)f2bf(v[1]) << 16); o[1] = (unsigned)f2bf(v[2]) | ((unsigned)f2bf(v[3]) << 16);
                            *(u32x2*)(pp + (size_t)row * DM + col) = o;
                        }
                    }
            }
    }
};
struct EpiPLE {
    float* x; bfraw* pp; float* ssq;
    __device__ __forceinline__ void operator()(const AccT& acc, const Unit& u, int wr, int wc, int fr, int fq) const {
        const int row_b = u.pm * 256 + wr * 64 + fr, col_b = u.pn * 256 + wc * 32 + fq * 4;
#pragma unroll
        for (int bt = 0; bt < 8; ++bt) {
            const int ai = bt >> 2, m = bt & 3;
            const int row = row_b + ai * 128 + m * 16;
            f32x4 xv[4]; u32x2 pr[4];
#pragma unroll
            for (int q = 0; q < 4; ++q) {
                const size_t o = (size_t)row * DM + col_b + (q >> 1) * 128 + (q & 1) * 16;
                xv[q] = *(const f32x4*)(x + o); pr[q] = *(const u32x2*)(pp + o);
            }
            float part = 0.f;
#pragma unroll
            for (int q = 0; q < 4; ++q) {
                const int bj = q >> 1, n = q & 1;
                const size_t o = (size_t)row * DM + col_b + bj * 128 + n * 16;
                const f32x4 a = acc[ai][bj][m][n]; f32x4 v;
                v[0] = xv[q][0] + sigmoidf_(a[0]) * __uint_as_float(pr[q][0] << 16);
                v[1] = xv[q][1] + sigmoidf_(a[1]) * __uint_as_float(pr[q][0] & 0xffff0000u);
                v[2] = xv[q][2] + sigmoidf_(a[2]) * __uint_as_float(pr[q][1] << 16);
                v[3] = xv[q][3] + sigmoidf_(a[3]) * __uint_as_float(pr[q][1] & 0xffff0000u);
                *(f32x4*)(x + o) = v;
                st_bf4(pp + o, v);
                part += (v[0] * v[0] + v[1] * v[1]) + (v[2] * v[2] + v[3] * v[3]);
            }
            part += __shfl_xor(part, 16); part += __shfl_xor(part, 32);
            if (fq == 0) ssq[(size_t)row * 32 + u.pn * 4 + wc] = part;
        }
    }
};

__device__ __forceinline__ void conv_mat(LAS unsigned char* lds, const float* src, int ld_src, int K, int ncols, int ncols_pad, bfraw* dst, const float* gain, int blk, int off) {
    const int tid = otid();
    const int nk = K / 64, nn = ncols_pad / 64, ntiles = nk * nn, G = gridDim.x;
    const int lkk = tid >> 4, ln = (tid & 15) * 4;
    const int sn = tid >> 3, skg = tid & 7;
    f32x4 cur[2][2], nxt[2][2];
    auto load = [&](int t, f32x4 (&r)[2]) {
        const int k0 = (t % nk) * 64, n0 = (t / nk) * 64;
#pragma unroll
        for (int i = 0; i < 2; ++i) {
            const int kk = lkk + i * 32;
            f32x4 v = (f32x4){0.f, 0.f, 0.f, 0.f};
            if (t < ntiles && n0 + ln + 3 < ncols) { v = *(const f32x4*)(src + (size_t)(k0 + kk) * ld_src + n0 + ln); if (gain) v = v * gain[k0 + kk]; }
            r[i] = v;
        }
    };
    int t = blockIdx.x;
    if (t < ntiles) { load(t, cur[0]); load(t + G, cur[1]); }
    for (; t < ntiles; t += 2 * G) {
        const int tn = t + 2 * G;
        if (tn < ntiles) { load(tn, nxt[0]); load(tn + G, nxt[1]); }
        __syncthreads();
#pragma unroll
        for (int u = 0; u < 2; ++u) {
            LAS float* tile = (LAS float*)lds + u * (64 * 65);
#pragma unroll
            for (int i = 0; i < 2; ++i)
#pragma unroll
                for (int j = 0; j < 4; ++j) tile[(lkk + i * 32) * 65 + ln + j] = cur[u][i][j];
        }
        __syncthreads();
#pragma unroll
        for (int u = 0; u < 2; ++u) {
            const int tt = t + u * G;
            if (tt < ntiles) {
                const LAS float* tile = (const LAS float*)lds + u * (64 * 65);
                const int k0 = (tt % nk) * 64, n0 = (tt / nk) * 64;
                const int nglob = n0 + sn;
                const int drow = blk ? (nglob / blk) * (2 * blk) + off + (nglob % blk) : nglob;
                u32x4 o;
#pragma unroll
                for (int j = 0; j < 4; ++j) o[j] = pack2(tile[(skg * 8 + 2 * j) * 65 + sn], tile[(skg * 8 + 2 * j + 1) * 65 + sn]);
                *(u32x4*)(dst + (size_t)drow * K + k0 + skg * 8) = o;
            }
        }
#pragma unroll
        for (int u = 0; u < 2; ++u) { cur[u][0] = nxt[u][0]; cur[u][1] = nxt[u][1]; }
    }
    __syncthreads();
}

__device__ __forceinline__ void phase_conv(CPR P, LAS unsigned char* lds, int layer) {
    bfraw* W = (bfraw*)(P.ws + WS_W);
    const float* nm = P.in[2] + layer * DM; const float* nf = P.in[3] + layer * DM;
    if (layer == 0) {
        const float* wi = P.in[4];
        conv_mat(lds, wi + 0, EVEN_COLS, DM, 2048, 2048, W + W_IN, nm, 0, 0);
        conv_mat(lds, wi + 3072, EVEN_COLS, DM, 3072, 3072, W + W_IN + (size_t)2048 * DM, nm, 0, 0);
        conv_mat(lds, wi + 7168, EVEN_COLS, DM, 8, 256, W + W_IN + (size_t)5120 * DM, nm, 0, 0);
        conv_mat(lds, wi + 2048, EVEN_COLS, DM, 1024, 1024, W + W_IN + (size_t)5376 * DM, nm, 0, 0);
        conv_mat(lds, wi + 6144, EVEN_COLS, DM, 1024, 1024, W + W_IN + (size_t)6400 * DM, nm, 0, 0);
        conv_mat(lds, P.in[7], DM, DM, DM, DM, W + W_OUT, nullptr, 0, 0);
    } else {
        const float* wi = P.in[8];
        conv_mat(lds, wi + 0, ODD_COLS, DM, 2048, 2048, W + W_IN, nm, 0, 0);
        conv_mat(lds, wi + 3072, ODD_COLS, DM, 1792, 1792, W + W_IN + (size_t)2048 * DM, nm, 0, 0);
        conv_mat(lds, wi + 5120, ODD_COLS, DM, 256, 256, W + W_IN + (size_t)3840 * DM, nm, 0, 0);
        conv_mat(lds, wi + 5632, ODD_COLS, DM, 24, 256, W + W_IN + (size_t)4096 * DM, nm, 0, 0);
        conv_mat(lds, wi + 2048, ODD_COLS, DM, 1024, 1024, W + W_IN + (size_t)4352 * DM, nm, 0, 0);
        conv_mat(lds, wi + 4864, ODD_COLS, DM, 256, 256, W + W_IN + (size_t)5376 * DM, nm, 0, 0);
        conv_mat(lds, wi + 5376, ODD_COLS, DM, 256, 256, W + W_IN + (size_t)5632 * DM, nm, 0, 0);
        conv_mat(lds, P.in[14], DM, DM, DM, DM, W + W_OUT, nullptr, 0, 0);
        for (int kv = 0; kv < 2; ++kv) {
            conv_mat(lds, P.in[12] + (size_t)kv * 4096 * 128, 128, 4096, 128, 128, W + W_C1 + (size_t)kv * 128 * 4096, nullptr, 0, 0);
            conv_mat(lds, P.in[13] + (size_t)kv * 128 * 128, 128, 128, 128, 128, W + W_C2 + (size_t)kv * 128 * 128, nullptr, 0, 0);
        }
        {
            const int tid = otid(), wave = tid >> 6, lane = tid & 63;
            for (int o = blockIdx.x * 8 + wave; o < 256; o += gridDim.x * 8) {
                const int kv = o >> 7, e = o & 127;
                const float* pos = P.in[11] + (size_t)kv * 4096; const float* w1 = P.in[12] + (size_t)kv * 4096 * 128;
                float s = 0.f;
#pragma unroll 16
                for (int j = 0; j < 64; ++j) { const int i = lane + 64 * j; s += pos[i] * w1[(size_t)i * 128 + e]; }
                s = wsum(s);
                if (lane == 0) ((float*)(P.ws + WS_PBIAS))[o] = s;
            }
        }
        {
            const int gt = blockIdx.x * NTHREADS + otid();
            if (gt < S) ((float*)(P.ws + WS_RINV))[gt] = row_rinv((const float*)(P.ws + WS_SSQ), gt);
        }
        {
            bfraw* z = (bfraw*)(P.ws + WS_Z);
            const int gt = blockIdx.x * NTHREADS + otid();
            if (gt < 4 * 32 * 128) {
                const int which = gt / (32 * 128), rem = gt % (32 * 128);
                const size_t b = (which < 2 ? Z1_CK : Z1_CV) + (size_t)(which & 1) * CKV_HS + (size_t)S * 128 + rem;
                z[b] = 0;
            }
        }
    }
    const int l = layer;
    conv_mat(lds, P.in[16] + (size_t)l * DM * DFF, DFF, DM, DFF, DFF, W + W_GU, nf, 128, 0);
    conv_mat(lds, P.in[17] + (size_t)l * DM * DFF, DFF, DM, DFF, DFF, W + W_GU, nf, 128, 128);
    conv_mat(lds, P.in[18] + (size_t)l * DFF * DM, DM, DFF, DM, DM, W + W_D, nullptr, 0, 0);
    conv_mat(lds, P.in[19] + (size_t)l * DM * DM, DM, DM, DM, DM, W + W_PG, nullptr, 0, 0);
    conv_mat(lds, P.in[20] + (size_t)l * PLE * DM, DM, PLE, DM, DM, W + W_PP, nullptr, 0, 0);
}

__device__ __forceinline__ void phase_prep(CPR P) {
    const int tid = otid(), wave = tid >> 6, lane = tid & 63;
    const float* x = P.in[0]; bfraw* xb = (bfraw*)(P.ws + WS_XB); float* ssq = (float*)(P.ws + WS_SSQ);
    for (int row = blockIdx.x * 8 + wave; row < S; row += gridDim.x * 8) {
        float s = 0.f;
#pragma unroll
        for (int i = 0; i < 8; ++i) {
            const size_t o = (size_t)row * DM + i * 256 + lane * 4;
            f32x4 v = *(const f32x4*)(x + o);
            s += (v[0] * v[0] + v[1] * v[1]) + (v[2] * v[2] + v[3] * v[3]);
            st_bf4(xb + o, v);
        }
        s = wsum(s);
        if (lane < 32) ssq[(size_t)row * 32 + lane] = lane == 0 ? s : 0.f;
        if (lane == 0) ((float*)(P.ws + WS_RINV))[row] = rsqrtf(s * (1.0f / 2048.0f) + EPS);
    }
    if (blockIdx.x == 0 && tid < 8) ((unsigned*)(P.ws + WS_KMAX))[tid] = 0u;
    const float* p = P.in[1]; bfraw* pb = (bfraw*)(P.ws + WS_PB);
    const size_t n4 = (size_t)2 * S * PLE / 4;
    for (size_t i = (size_t)blockIdx.x * NTHREADS + tid; i < n4; i += (size_t)gridDim.x * NTHREADS) st_bf4(pb + i * 4, *(const f32x4*)(p + i * 4));
}

__device__ __forceinline__ void phase_final(CPR P) {
    const int tid = otid(), wave = tid >> 6, lane = tid & 63;
    float* x = P.out; const float* ssq = (const float*)(P.ws + WS_SSQ); const float* g = P.in[21];
    for (int row = blockIdx.x * 8 + wave; row < S; row += gridDim.x * 8) {
        const float ri = row_rinv(ssq, row);
#pragma unroll
        for (int i = 0; i < 8; ++i) {
            const size_t o = (size_t)row * DM + i * 256 + lane * 4;
            f32x4 v = *(const f32x4*)(x + o), gv = *(const f32x4*)(g + i * 256 + lane * 4);
            *(f32x4*)(x + o) = v * ri * gv;
        }
    }
}

__device__ __forceinline__ void fl_rows(CPR P, LAS unsigned char* lds) {
    const bfraw* xb = (const bfraw*)(P.ws + WS_XB); const bfraw* wfl = (const bfraw*)(P.ws + WS_W) + W_IN + (size_t)5120 * DM;
    const float* ssq = (const float*)(P.ws + WS_SSQ); float* fl = (float*)(P.ws + WS_FL);
    const int tid = otid(), wave = tid >> 6, lane = tid & 63;
    __syncthreads();
#pragma unroll
    for (int i = 0; i < 4; ++i) { const int c = tid + i * 512; *(LAS u32x4*)(lds + c * 16) = *(const u32x4*)(wfl + (size_t)c * 8); }
    __syncthreads();
    for (int row = blockIdx.x * 8 + wave; row < S; row += gridDim.x * 8) {
        float xv[32];
#pragma unroll
        for (int q = 0; q < 4; ++q) {
            const u32x4 v = *(const u32x4*)(xb + (size_t)row * DM + lane * 32 + q * 8);
#pragma unroll
            for (int e = 0; e < 4; ++e) { xv[q * 8 + 2 * e] = __uint_as_float(v[e] << 16); xv[q * 8 + 2 * e + 1] = __uint_as_float(v[e] & 0xffff0000u); }
        }
        float acc[8];
#pragma unroll
        for (int j = 0; j < 8; ++j) {
            float a = 0.f;
#pragma unroll
            for (int q = 0; q < 4; ++q) {
                const u32x4 w = *(const LAS u32x4*)(lds + j * 4096 + lane * 64 + q * 16);
#pragma unroll
                for (int e = 0; e < 4; ++e) { a += xv[q * 8 + 2 * e] * __uint_as_float(w[e] << 16); a += xv[q * 8 + 2 * e + 1] * __uint_as_float(w[e] & 0xffff0000u); }
            }
            acc[j] = wsum(a);
            __builtin_amdgcn_sched_barrier(0);
        }
        const float ri = ((const float*)(P.ws + WS_RINV))[row];
        if (lane < 8) {
            float v = acc[0];
#pragma unroll
            for (int j = 1; j < 8; ++j) v = (lane == j) ? acc[j] : v;
            fl[(size_t)lane * S + row] = v * ri;
        }
    }
    __syncthreads();
}

__device__ __forceinline__ void mm128(const LAS unsigned char* A, int astr, const LAS unsigned char* B, int bstr, int Kdim, f32x16 (&acc)[2]) {
    const int tid = otid(), w = tid >> 6, lane = tid & 63, ql = lane & 31, g = lane >> 5;
    const LAS unsigned char* ap = A + ((w >> 1) * 32 + ql) * astr + g * 16;
    const LAS unsigned char* bp0 = B + ((w & 1) * 64 + ql) * bstr + g * 16;
    const LAS unsigned char* bp1 = bp0 + 32 * bstr;
    (void)Kdim;
    bf16x8 a = *(const LAS bf16x8*)(ap), b0 = *(const LAS bf16x8*)(bp0), b1 = *(const LAS bf16x8*)(bp1);
#pragma unroll
    for (int kk = 0; kk < 8; ++kk) {
        bf16x8 na = a, nb0 = b0, nb1 = b1;
        if (kk + 1 < 8) { na = *(const LAS bf16x8*)(ap + (kk + 1) * 32); nb0 = *(const LAS bf16x8*)(bp0 + (kk + 1) * 32); nb1 = *(const LAS bf16x8*)(bp1 + (kk + 1) * 32); }
        __builtin_amdgcn_sched_barrier(0);
        acc[0] = __builtin_amdgcn_mfma_f32_32x32x16_bf16(a, b0, acc[0], 0, 0, 0);
        acc[1] = __builtin_amdgcn_mfma_f32_32x32x16_bf16(a, b1, acc[1], 0, 0, 0);
        __builtin_amdgcn_sched_barrier(0);
        a = na; b0 = nb0; b1 = nb1;
    }
}
constexpr int T128 = 272;
__device__ __forceinline__ void stage128(LAS unsigned char* dst, const bfraw* src, size_t ld) {
    const int tid = otid();
#pragma unroll
    for (int i = 0; i < 4; ++i) { const int c = tid + i * 512, row = c >> 4, col = c & 15; *(LAS u32x4*)(dst + row * T128 + col * 16) = *(const u32x4*)(src + (size_t)row * ld + col * 8); }
}
__device__ __forceinline__ float lgam2_of(int h) { return log1pf(-exp2f(-5.0f - (float)h)) * LOG2E; }

__device__ __forceinline__ void ret_upd_item(CPR P, LAS unsigned char* lds, int h, int n) {
    const bfraw* z = (const bfraw*)(P.ws + WS_Z); float* st = (float*)(P.ws + WS_XB);
    const int tid = otid();
    const float lg = lgam2_of(h);
    __syncthreads();
    stage128(lds, z + Z0_VT + (size_t)(h * 128) * S + n * 128, S);
    LAS unsigned char* B = lds + 128 * T128;
    const bfraw* kp = z + Z0_RQK + ((size_t)(8 + h) * S + n * 128) * 128;
#pragma unroll
    for (int i = 0; i < 4; ++i) {
        const int c = tid + i * 512, s = c >> 4, col = c & 15;
        const u32x4 v = *(const u32x4*)(kp + (size_t)s * 128 + col * 8);
        const float kw = fexp2(lg * (float)(127 - s)) * 0.08838834764831845f;
#pragma unroll
        for (int j = 0; j < 4; ++j) {
            const float lo = __uint_as_float(v[j] << 16) * kw, hi = __uint_as_float(v[j] & 0xffff0000u) * kw;
            *(LAS bfraw*)(B + (col * 8 + 2 * j) * T128 + s * 2) = f2bf(lo);
            *(LAS bfraw*)(B + (col * 8 + 2 * j + 1) * T128 + s * 2) = f2bf(hi);
        }
    }
    __syncthreads();
    f32x16 acc[2]; acc[0] = (f32x16)(0.f); acc[1] = (f32x16)(0.f);
    mm128(lds, T128, B, T128, 128, acc);
    const int w = tid >> 6, lane = tid & 63, ql = lane & 31, g = lane >> 5;
    float* o = st + ((size_t)(h * 128 + n) * 128) * 128;
#pragma unroll
    for (int nb = 0; nb < 2; ++nb)
#pragma unroll
        for (int r = 0; r < 16; ++r) {
            const int row = (w >> 1) * 32 + (r & 3) + 8 * (r >> 2) + 4 * g, col = (w & 1) * 64 + nb * 32 + ql;
            o[(size_t)row * 128 + col] = acc[nb][r];
        }
}
__device__ __forceinline__ void phase_ret_scan(CPR P) {
    float* st = (float*)(P.ws + WS_XB);
    for (int e = blockIdx.x * NTHREADS + otid(); e < 8 * 16384; e += gridDim.x * NTHREADS) {
        const int h = e >> 14, idx = e & 16383;
        const float decay = fexp2(lgam2_of(h) * 128.0f);
        float* p = st + (size_t)h * 128 * 16384 + idx;
        float state = 0.f;
        for (int n = 0; n < 128; n += 8) {
            float u[8];
#pragma unroll
            for (int i = 0; i < 8; ++i) u[i] = p[(size_t)(n + i) * 16384];
#pragma unroll
            for (int i = 0; i < 8; ++i) { p[(size_t)(n + i) * 16384] = state; state = state * decay + u[i]; }
        }
    }
}
__device__ __forceinline__ void ret_out_item(CPR P, LAS unsigned char* lds, int h, int n) {
    const bfraw* z = (const bfraw*)(P.ws + WS_Z); const float* st = (const float*)(P.ws + WS_XB); bfraw* mix = (bfraw*)(P.ws + WS_M);
    const int tid = otid(), w = tid >> 6, lane = tid & 63, ql = lane & 31, g = lane >> 5;
    const float lg = lgam2_of(h);
    LAS unsigned char* Qs = lds; LAS unsigned char* Ks = lds + 128 * T128; LAS unsigned char* Vs = lds + 2 * 128 * T128; LAS unsigned char* Xs = lds + 3 * 128 * T128;
    __syncthreads();
    stage128(Qs, z + Z0_RQK + ((size_t)h * S + n * 128) * 128, 128);
    stage128(Ks, z + Z0_RQK + ((size_t)(8 + h) * S + n * 128) * 128, 128);
    stage128(Vs, z + Z0_VT + (size_t)(h * 128) * S + n * 128, S);
    {
        const float* sp = st + ((size_t)(h * 128 + n) * 128) * 128;
#pragma unroll
        for (int i = 0; i < 8; ++i) {
            const int c = tid + i * 512, row = c >> 5, col = c & 31;
            const f32x4 v = *(const f32x4*)(sp + (size_t)row * 128 + col * 4);
            u32x2 o; o[0] = pack2(v[0], v[1]); o[1] = pack2(v[2], v[3]);
            *(LAS u32x2*)(Xs + row * T128 + col * 8) = o;
        }
    }
    __syncthreads();
    f32x16 accY[2], accA[2];
    accY[0] = (f32x16)(0.f); accY[1] = (f32x16)(0.f); accA[0] = (f32x16)(0.f); accA[1] = (f32x16)(0.f);
    mm128(Qs, T128, Xs, T128, 128, accY);
    mm128(Qs, T128, Ks, T128, 128, accA);
#pragma unroll
    for (int nb = 0; nb < 2; ++nb)
#pragma unroll
        for (int r = 0; r < 16; ++r) {
            const int c = (w >> 1) * 32 + (r & 3) + 8 * (r >> 2) + 4 * g, col = (w & 1) * 64 + nb * 32 + ql;
            accY[nb][r] *= fexp2(lg * (float)(c + 1));
            const int rel = c - col;
            accA[nb][r] = rel >= 0 ? accA[nb][r] * 0.08838834764831845f * fexp2(lg * (float)rel) : 0.f;
        }
    __syncthreads();
#pragma unroll
    for (int nb = 0; nb < 2; ++nb)
#pragma unroll
        for (int r = 0; r < 16; ++r) {
            const int c = (w >> 1) * 32 + (r & 3) + 8 * (r >> 2) + 4 * g, col = (w & 1) * 64 + nb * 32 + ql;
            *(LAS bfraw*)(Xs + c * T128 + col * 2) = f2bf(accA[nb][r]);
        }
    __syncthreads();
    mm128(Xs, T128, Vs, T128, 128, accY);
    __syncthreads();
    LAS float* Ys = (LAS float*)lds;
#pragma unroll
    for (int nb = 0; nb < 2; ++nb)
#pragma unroll
        for (int r = 0; r < 16; ++r) {
            const int c = (w >> 1) * 32 + (r & 3) + 8 * (r >> 2) + 4 * g, col = (w & 1) * 64 + nb * 32 + ql;
            Ys[c * 132 + col] = accY[nb][r];
        }
    __syncthreads();
    const float* gn = P.in[5];
    const bfraw* rg = z + Z0_RG;
    bfraw gq0[16], gq1[16];
#pragma unroll
    for (int i = 0; i < 16; ++i) { const int t = n * 128 + w * 16 + i; gq0[i] = rg[(size_t)t * 1024 + h * 128 + lane]; gq1[i] = rg[(size_t)t * 1024 + h * 128 + 64 + lane]; }
    const float gn0 = gn[h * 128 + lane], gn1 = gn[h * 128 + 64 + lane];
#pragma unroll
    for (int i = 0; i < 16; ++i) {
        const int c = w * 16 + i, t = n * 128 + c;
        const float v0 = Ys[c * 132 + lane], v1 = Ys[c * 132 + 64 + lane];
        const float mean = wsum(v0 + v1) * (1.0f / 128.0f);
        const float d0 = v0 - mean, d1 = v1 - mean;
        const float var = wsum(d0 * d0 + d1 * d1) * (1.0f / 128.0f);
        const float rstd = rsqrtf(var + EPS);
        const float g0 = bf2f(gq0[i]), g1 = bf2f(gq1[i]);
        mix[(size_t)t * DM + h * 128 + lane] = f2bf(d0 * rstd * gn0 * siluf_(g0));
        mix[(size_t)t * DM + h * 128 + 64 + lane] = f2bf(d1 * rstd * gn1 * siluf_(g1));
    }
}
__device__ __forceinline__ void fox_cumsum_item(CPR P, LAS unsigned char* lds, int h) {
    const float* fl = (const float*)(P.ws + WS_FL) + (size_t)h * S; float* c2 = (float*)(P.ws + WS_C2) + (size_t)h * S;
    const float fb = P.in[6][h];
    const int tid = otid();
    LAS double* sc = (LAS double*)lds;
    __syncthreads();
    float ls[32]; double tot = 0.0;
#pragma unroll
    for (int i = 0; i < 32; ++i) { const float x = fl[tid * 32 + i] + fb; ls[i] = fminf(x, 0.f) - log1pf(__expf(-fabsf(x))); tot += (double)ls[i]; }
    sc[tid] = tot;
    __syncthreads();
    for (int off = 1; off < 512; off <<= 1) {
        double v = tid >= off ? sc[tid - off] : 0.0;
        __syncthreads();
        sc[tid] += v;
        __syncthreads();
    }
    double run = sc[tid] - tot;
#pragma unroll
    for (int i = 0; i < 32; ++i) { run += (double)ls[i]; c2[tid * 32 + i] = (float)(run * 1.4426950408889634); }
    __syncthreads();
}

__device__ __forceinline__ void fox_kmax_item(CPR P, LAS unsigned char* lds, int h, int c) {
    const bfraw* k = (const bfraw*)(P.ws + WS_Z) + Z0_FQK + ((size_t)(8 + h) * S + (size_t)c * 2048) * 128;
    const int tid = otid();
    float mx = 0.f;
    for (int i = 0; i < 4; ++i) {
        const bfraw* row = k + (size_t)(tid * 4 + i) * 128;
        float s = 0.f;
#pragma unroll
        for (int q = 0; q < 16; ++q) {
            const u32x4 v = *(const u32x4*)(row + q * 8);
#pragma unroll
            for (int e = 0; e < 4; ++e) { const float lo = __uint_as_float(v[e] << 16), hi = __uint_as_float(v[e] & 0xffff0000u); s += lo * lo + hi * hi; }
        }
        mx = fmaxf(mx, s);
    }
#pragma unroll
    for (int o = 32; o >= 1; o >>= 1) mx = fmaxf(mx, __shfl_xor(mx, o));
    if ((tid & 63) == 0) atomicMax((unsigned*)(P.ws + WS_KMAX) + h, __float_as_uint(mx));
}

constexpr int F_KB0 = 0, F_KBS = 17408, F_VB0 = 34816, F_VBS = 18432, F_CT = 71680, F_TB = 72192, F_UN = 74304, F_IMP = 74752;
enum { M_FOX = 0, M_DIFF = 1, M_WIN = 2, M_SLC = 3, M_CMP = 4 };
__device__ __forceinline__ f32x16 mfma32(bf16x8 a, bf16x8 b, f32x16 c) { return __builtin_amdgcn_mfma_f32_32x32x16_bf16(a, b, c, 0, 0, 0); }
__device__ __forceinline__ int t5_bucket(int d) {
    if (d < 16) return d;
    int b = 16 + (int)(logf((float)d / 16.0f) / 2.0794415416798357f * 16.0f);
    return b < 31 ? b : 31;
}
__device__ __forceinline__ void build_t5(LAS float* tb, const float* table, int col) {
    const int d = otid();
    if (d <= 128) tb[d] = (table[t5_bucket(d) * 16 + col] - table[31 * 16 + col]) * LOG2E;
}
__device__ __forceinline__ int next_sel(const LAS unsigned* un, int j, int hi) {
    int jj = j + 1;
    if (jj > hi) return hi + 1;
    int w = jj >> 5; unsigned mask = un[w] & (~0u << (jj & 31));
    for (;;) {
        if (mask) { const int r = w * 32 + __ffs(mask) - 1; return r <= hi ? r : hi + 1; }
        ++w; if (w > (hi >> 5)) return hi + 1;
        mask = un[w];
    }
}

template <int DK> struct StageRegs { u32x4 k[DK == 128 ? 2 : 1]; u32x4 v[2]; float c; };

template <int MODE, int DK, bool PASS2>
__device__ __forceinline__ void flash_loop(LAS unsigned char* lds, const bfraw* Kg, int k_ld, const bfraw* Vtg, int vt_ld, const float* cg2,
                                           int tile_lo, int tile_hi, const bf16x8 (&qf)[DK / 16], int t_lane, int t_wmin, int t_wmax, float sl2,
                                           const LAS float* tb, float qnb,
                                           f32x16 (&O)[4], float& m_run, float& l_run, LAS float* impw) {
    constexpr int KSTR = DK * 2 + 16;
    const int tid = otid(), lane = tid & 63, ql = lane & 31, g = lane >> 5;
    const int prow = (ql & 19) | ((ql & 4) << 1) | ((ql & 8) >> 1);
    const LAS unsigned* un = (const LAS unsigned*)(lds + F_UN);
    const float rsl2 = 1.0f / sl2;
    StageRegs<DK> sr;
    auto load_tile = [&](int j) {
        const int kv0 = j * 64;
        if (DK == 128) {
#pragma unroll
            for (int i = 0; i < 2; ++i) { const int c = tid + i * 512, row = c >> 4, col = c & 15; sr.k[i] = *(const u32x4*)((const char*)Kg + (unsigned)(((kv0 + row) * k_ld + col * 8) * 2)); }
        } else {
            const int row = tid >> 3, col = tid & 7; sr.k[0] = *(const u32x4*)((const char*)Kg + (unsigned)(((kv0 + row) * k_ld + col * 8) * 2));
        }
        if (!PASS2) {
#pragma unroll
            for (int i = 0; i < 2; ++i) { const int c = tid + i * 512, row = c >> 3, col = c & 7; sr.v[i] = *(const u32x4*)((const char*)Vtg + (unsigned)((row * vt_ld + kv0 + col * 8) * 2)); }
        }
        if (MODE == M_FOX) { if (tid < 64) sr.c = cg2[kv0 + tid]; }
    };
    auto write_tile = [&](int buf) {
        if (DK == 128) {
#pragma unroll
            for (int i = 0; i < 2; ++i) { const int c = tid + i * 512, row = c >> 4, col = c & 15; *(LAS u32x4*)(lds + F_KB0 + buf * F_KBS + row * KSTR + col * 16) = sr.k[i]; }
        } else {
            const int row = tid >> 3, col = tid & 7; *(LAS u32x4*)(lds + F_KB0 + buf * F_KBS + row * KSTR + col * 16) = sr.k[0];
        }
        if (!PASS2) {
#pragma unroll
            for (int i = 0; i < 2; ++i) { const int c = tid + i * 512, row = c >> 3, col = c & 7; *(LAS u32x4*)(lds + F_VB0 + buf * F_VBS + row * 144 + col * 16) = sr.v[i]; }
        }
        if (MODE == M_FOX) { if (tid < 64) *(LAS float*)(lds + F_CT + buf * 256 + tid * 4) = -sr.c * rsl2; }
    };
    int j = (MODE == M_SLC) ? next_sel(un, tile_lo - 1, tile_hi) : (MODE == M_FOX ? tile_hi : tile_lo);
    if (MODE != M_FOX && j > tile_hi) return;
    float carry = 0.f;
    load_tile(j); write_tile(0);
    __syncthreads();
    int buf = 0;
    for (;;) {
        const int jn = (MODE == M_SLC) ? next_sel(un, j, tile_hi) : (MODE == M_FOX ? j - 1 : j + 1);
        const bool has = (MODE == M_FOX) ? (jn >= tile_lo) : (jn <= tile_hi);
        if (has) load_tile(jn);
        bool dead = false;
        {
            const int kv0 = j * 64;
            const int pos_min = (MODE == M_CMP) ? 16 * kv0 + 31 : kv0;
            const int pos_max = (MODE == M_CMP) ? 16 * (kv0 + 63) + 31 : kv0 + 63;
            bool active = pos_min <= t_wmax;
            if (MODE == M_WIN) active = active && (t_wmin - pos_max < 512);
            bool selbit = true;
            if (MODE == M_SLC) {
                selbit = ((((const LAS unsigned*)impw)[j >> 5] >> (j & 31)) & 1u) != 0u;
                active = active && (__builtin_amdgcn_ballot_w64(selbit) != 0ull);
            }
            if (active) {
                f32x16 s0, s1;
                if (MODE == M_FOX) {
                    const LAS float* ct = (const LAS float*)(lds + F_CT + buf * 256) + 8 * g;
#pragma unroll
                    for (int q4 = 0; q4 < 4; ++q4) {
                        const f32x4 a = *(const LAS f32x4*)(ct + (q4 >> 1) * 16 + (q4 & 1) * 4), b = *(const LAS f32x4*)(ct + 32 + (q4 >> 1) * 16 + (q4 & 1) * 4);
#pragma unroll
                        for (int e = 0; e < 4; ++e) { s0[q4 * 4 + e] = a[e]; s1[q4 * 4 + e] = b[e]; }
                    }
                } else { s0 = (f32x16)(0.f); s1 = (f32x16)(0.f); }
                const LAS unsigned char* kb = lds + F_KB0 + buf * F_KBS + g * 16 + prow * KSTR;
                __builtin_amdgcn_s_setprio(1);
#pragma unroll
                for (int kk = 0; kk < DK / 16; ++kk) {
                    const bf16x8 a0 = *(const LAS bf16x8*)(kb + kk * 32);
                    const bf16x8 a1 = *(const LAS bf16x8*)(kb + 32 * KSTR + kk * 32);
                    s0 = mfma32(a0, qf[kk], s0); s1 = mfma32(a1, qf[kk], s1);
                }
                __builtin_amdgcn_s_setprio(0);
                const bool need_causal = pos_max > t_wmin;
                const bool need_bias = (MODE != M_FOX) && ((t_wmin - pos_max) < 128);
                const bool need_win = (MODE == M_WIN) && (t_wmax - pos_min >= 512);
                if (!PASS2 && !(need_causal || need_bias || need_win)) {
                    float mx = fmaxf(s0[0], s1[0]);
#pragma unroll
                    for (int r = 1; r < 16; ++r) mx = fmax3(mx, s0[r], s1[r]);
                    if (MODE == M_SLC) mx = selbit ? mx : NEG;
                    mx = xhalf_max(mx);
                    const float mxs = mx * sl2;
                    const float mn = (mxs > m_run + 8.0f) ? mxs : m_run;
                    const float alpha = fexp2(m_run - mn);
                    m_run = mn;
                    float nm = -mn;
                    if (MODE == M_SLC) nm = selbit ? nm : -__builtin_inff();
                    float ps0 = 0.f, ps1 = 0.f;
#pragma unroll
                    for (int r = 0; r < 16; ++r) {
                        s0[r] = fexp2(__builtin_fmaf(s0[r], sl2, nm)); s1[r] = fexp2(__builtin_fmaf(s1[r], sl2, nm));
                        ps0 += s0[r]; ps1 += s1[r];
                    }
                    l_run = l_run * alpha + (ps0 + ps1);
                    if (__builtin_amdgcn_ballot_w64(alpha != 1.0f) != 0ull) {
#pragma unroll
                        for (int db = 0; db < 4; ++db)
#pragma unroll
                            for (int r = 0; r < 16; ++r) O[db][r] *= alpha;
                    }
                } else {
#pragma unroll
                    for (int r = 0; r < 16; ++r) { s0[r] *= sl2; s1[r] *= sl2; }
                    if (need_bias || need_causal || need_win) {
#pragma unroll
                        for (int i = 0; i < 32; ++i) {
                            const int s = kv0 + (i >> 3) * 16 + 8 * g + (i & 7);
                            const int dist = t_lane - ((MODE == M_CMP) ? 16 * s + 31 : s);
                            float v = (i < 16) ? s0[i & 15] : s1[i & 15];
                            if (need_bias) { const int di = dist < 0 ? 0 : (dist > 128 ? 128 : dist); v += tb[di]; }
                            bool msk = dist < 0;
                            if (MODE == M_WIN) msk = msk || dist >= 512;
                            if (msk) v = NEG;
                            if (i < 16) s0[i & 15] = v; else s1[i & 15] = v;
                            if ((i & 7) == 7) __builtin_amdgcn_sched_barrier(0);
                        }
                    }
                    if (MODE == M_SLC) {
                        if (!selbit) {
#pragma unroll
                            for (int r = 0; r < 16; ++r) { s0[r] = NEG; s1[r] = NEG; }
                        }
                    }
                    if (!PASS2) {
                        float mx = fmaxf(s0[0], s1[0]);
#pragma unroll
                        for (int r = 1; r < 16; ++r) mx = fmax3(mx, s0[r], s1[r]);
                        mx = xhalf_max(mx);
                        const float mn = (mx > m_run + 8.0f) ? mx : m_run;
                        const float alpha = fexp2(m_run - mn);
                        m_run = mn;
                        float ps0 = 0.f, ps1 = 0.f;
#pragma unroll
                        for (int r = 0; r < 16; ++r) { s0[r] = fexp2(s0[r] - mn); s1[r] = fexp2(s1[r] - mn); ps0 += s0[r]; ps1 += s1[r]; }
                        l_run = l_run * alpha + (ps0 + ps1);
                        if (__builtin_amdgcn_ballot_w64(alpha != 1.0f) != 0ull) {
#pragma unroll
                            for (int db = 0; db < 4; ++db)
#pragma unroll
                                for (int r = 0; r < 16; ++r) O[db][r] *= alpha;
                        }
                    }
                }
                if (!PASS2) {
                    bf16x8 pf[4];
#pragma unroll
                    for (int k2 = 0; k2 < 4; ++k2) {
                        u32x4 pk;
#pragma unroll
                        for (int e = 0; e < 4; ++e) pk[e] = (k2 < 2) ? pack2(s0[(k2 & 1) * 8 + 2 * e], s0[(k2 & 1) * 8 + 2 * e + 1]) : pack2(s1[(k2 & 1) * 8 + 2 * e], s1[(k2 & 1) * 8 + 2 * e + 1]);
                        pf[k2] = __builtin_bit_cast(bf16x8, pk);
                    }
                    const LAS unsigned char* vb = lds + F_VB0 + buf * F_VBS + ql * 144 + g * 16;
                    __builtin_amdgcn_s_setprio(1);
#pragma unroll
                    for (int db = 0; db < 4; ++db)
#pragma unroll
                        for (int k2 = 0; k2 < 4; ++k2) {
                            const bf16x8 vf = *(const LAS bf16x8*)(vb + db * 32 * 144 + k2 * 32);
                            O[db] = mfma32(vf, pf[k2], O[db]);
                            if (k2 == 3 && (db & 1)) __builtin_amdgcn_sched_barrier(0);
                        }
                    __builtin_amdgcn_s_setprio(0);
                    if (MODE == M_FOX) {
                        if (has) { const float cn = cg2[jn * 64 + 63]; dead = __builtin_amdgcn_ballot_w64(!((qnb - cn) - m_run < -160.0f)) == 0ull; }
                    }
                } else {
                    float I0[4], I1[4], e7[4];
#pragma unroll
                    for (int c = 0; c < 4; ++c) {
                        float p[8];
#pragma unroll
                        for (int e = 0; e < 8; ++e) p[e] = fexp2(((c < 2) ? s0[(c & 1) * 8 + e] : s1[(c & 1) * 8 + e]) - m_run) * l_run;
                        I0[c] = (p[0] + p[1]) + (p[2] + p[3]);
                        I1[c] = (p[4] + p[5]) + (p[6] + p[7]) + p[3];
                        e7[c] = p[7];
                    }
                    float rc[4];
#pragma unroll
                    for (int c = 0; c < 4; ++c) rc[c] = __shfl_xor(e7[c], 32);
                    if (g == 1) {
#pragma unroll
                        for (int c = 0; c < 4; ++c) I0[c] += rc[c];
                    } else {
                        I0[0] += carry; I0[1] += rc[0]; I0[2] += rc[1]; I0[3] += rc[2];
                        carry = rc[3];
                    }
#pragma unroll
                    for (int c = 0; c < 4; ++c) {
                        I0[c] += dppf<0xB1>(I0[c]); I0[c] += dppf<0x4E>(I0[c]);
                        I1[c] += dppf<0xB1>(I1[c]); I1[c] += dppf<0x4E>(I1[c]);
                    }
                    if ((ql & 3) == 0) {
#pragma unroll
                        for (int c = 0; c < 4; ++c) {
                            impw[(ql >> 2) * 256 + 16 * j + 2 * g + 4 * c] = I0[c];
                            impw[(ql >> 2) * 256 + 16 * j + 2 * g + 4 * c + 1] = I1[c];
                        }
                    }
                }
            }
        }
        if (has) write_tile(buf ^ 1);
        if (MODE == M_FOX) { if (__syncthreads_and(dead ? 1 : 0)) break; }
        else __syncthreads();
        if (!has) break;
        j = jn; buf ^= 1;
    }
}

__device__ __forceinline__ void load_q128(bf16x8 (&qf)[8], const bfraw* qrow, int g) {
#pragma unroll
    for (int kk = 0; kk < 8; ++kk) qf[kk] = *(const bf16x8*)(qrow + kk * 16 + g * 8);
}

__device__ __forceinline__ void fox_item(CPR P, LAS unsigned char* lds, int h, int qb) {
    const bfraw* z = (const bfraw*)(P.ws + WS_Z); bfraw* mix = (bfraw*)(P.ws + WS_M);
    const float* c2 = (const float*)(P.ws + WS_C2) + (size_t)h * S;
    const int tid = otid(), wave = tid >> 6, lane = tid & 63, ql = lane & 31, g = lane >> 5;
    const int q0 = qb * 256, t = q0 + wave * 32 + ql;
    bf16x8 qf[8];
    load_q128(qf, z + Z0_FQK + ((size_t)h * S + t) * 128, g);
    float qn2 = 0.f;
#pragma unroll
    for (int kk = 0; kk < 8; ++kk)
#pragma unroll
        for (int e = 0; e < 8; ++e) { const float v = bf2f((unsigned short)qf[kk][e]); qn2 += v * v; }
    qn2 += __shfl_xor(qn2, 32);
    const float kmax2 = __uint_as_float(((const unsigned*)(P.ws + WS_KMAX))[h]);
    const float qnb = sqrtf(qn2 * kmax2) * (0.08838834764831845f * LOG2E * 1.01f) + 1.0f;
    f32x16 O[4];
#pragma unroll
    for (int i = 0; i < 4; ++i) O[i] = (f32x16)(0.f);
    float m = NEG, l = 0.f;
    __syncthreads();
    flash_loop<M_FOX, 128, false>(lds, z + Z0_FQK + (size_t)(8 + h) * S * 128, 128, z + Z0_VT + (size_t)(1024 + h * 128) * S, S, c2,
                                  0, (q0 + 255) >> 6, qf, t, q0 + wave * 32, q0 + wave * 32 + 31, 0.08838834764831845f * LOG2E,
                                  nullptr, qnb, O, m, l, nullptr);
    l += __shfl_xor(l, 32);
    const float inv = 1.0f / l;
    bfraw* orow = mix + (size_t)t * DM + 1024 + h * 128 + 4 * g;
#pragma unroll
    for (int db = 0; db < 4; ++db)
#pragma unroll
        for (int r4 = 0; r4 < 4; ++r4) {
            f32x4 v; v[0] = O[db][r4 * 4] * inv; v[1] = O[db][r4 * 4 + 1] * inv; v[2] = O[db][r4 * 4 + 2] * inv; v[3] = O[db][r4 * 4 + 3] * inv;
            st_bf4(orow + db * 32 + r4 * 8, v);
        }
}

__device__ __forceinline__ void diff_item(CPR P, LAS unsigned char* lds, int h, int qb) {
    const bfraw* z = (const bfraw*)(P.ws + WS_Z); bfraw* mix = (bfraw*)(P.ws + WS_M);
    const int tid = otid(), wave = tid >> 6, lane = tid & 63, ql = lane & 31, g = lane >> 5;
    const int q0 = qb * 256, t = q0 + wave * 32 + ql;
    const float* lam = P.in[9];
    const float sa = wsum(lam[lane] * lam[64 + lane]), sb = wsum(lam[128 + lane] * lam[192 + lane]);
    const float lmbda = __expf(sa) - __expf(sb) + LINIT;
    LAS float* tb = (LAS float*)(lds + F_TB);
    __syncthreads();
    build_t5(tb, P.in[15], h);
    __syncthreads();
    LAS unsigned* hold = (LAS unsigned*)(lds + F_IMP) + otid();
    f32x16 O[4];
    for (int mp = 0; mp < 2; ++mp) {
        bf16x8 qf[4];
        const bfraw* qrow = z + Z1_DQK + ((size_t)(h * 2 + mp) * S + t) * 64;
#pragma unroll
        for (int kk = 0; kk < 4; ++kk) qf[kk] = *(const bf16x8*)(qrow + kk * 16 + g * 8);
#pragma unroll
        for (int i = 0; i < 4; ++i) O[i] = (f32x16)(0.f);
        float m = NEG, l = 0.f;
        flash_loop<M_DIFF, 64, false>(lds, z + Z1_DQK + (size_t)(16 + h * 2 + mp) * S * 64, 64, z + Z1_VT + (size_t)(h * 128) * S, S, nullptr,
                                      0, (q0 + 255) >> 6, qf, t, q0 + wave * 32, q0 + wave * 32 + 31, 0.125f * LOG2E,
                                      tb, 0.f, O, m, l, nullptr);
        l += __shfl_xor(l, 32);
        const float inv = 1.0f / l;
        if (mp == 0) {
#pragma unroll
            for (int db = 0; db < 4; ++db)
#pragma unroll
                for (int r = 0; r < 8; ++r) hold[(db * 8 + r) * 512] = pack2(O[db][2 * r] * inv, O[db][2 * r + 1] * inv);
        } else {
            float ss = 0.f;
#pragma unroll
            for (int db = 0; db < 4; ++db)
#pragma unroll
                for (int r = 0; r < 8; ++r) {
                    const unsigned hv = hold[(db * 8 + r) * 512];
                    const float a = __uint_as_float(hv << 16) - lmbda * (O[db][2 * r] * inv);
                    const float b = __uint_as_float(hv & 0xffff0000u) - lmbda * (O[db][2 * r + 1] * inv);
                    O[db][2 * r] = a; O[db][2 * r + 1] = b;
                    ss += a * a + b * b;
                }
            ss += __shfl_xor(ss, 32);
            const float rn = rsqrtf(ss * (1.0f / 128.0f) + EPS) * (1.0f - LINIT);
            const float* sg = P.in[10];
            bfraw* orow = mix + (size_t)t * DM + h * 128 + 4 * g;
#pragma unroll
            for (int db = 0; db < 4; ++db)
#pragma unroll
                for (int r4 = 0; r4 < 4; ++r4) {
                    const f32x4 gv = *(const f32x4*)(sg + db * 32 + r4 * 8 + 4 * g);
                    f32x4 v;
#pragma unroll
                    for (int e = 0; e < 4; ++e) v[e] = O[db][r4 * 4 + e] * rn * gv[e];
                    st_bf4(orow + db * 32 + r4 * 8, v);
                }
        }
    }
}

template <int MODE>
__device__ __forceinline__ void nsa_item(CPR P, LAS unsigned char* lds, int h, int qb) {
    const bfraw* z = (const bfraw*)(P.ws + WS_Z); bfraw* mix = (bfraw*)(P.ws + WS_M);
    bfraw* ocmp = (bfraw*)(P.ws + WS_XB); bfraw* owin = ocmp + (size_t)S * 1024;
    const float* gates = (const float*)(P.ws + WS_GATES);
    const unsigned* selg = (const unsigned*)(P.ws + WS_SEL);
    const int tid = otid(), wave = tid >> 6, lane = tid & 63, ql = lane & 31, g = lane >> 5;
    const int q0 = qb * 256, t = q0 + wave * 32 + ql, kvh = h >> 2;
    LAS float* tb = (LAS float*)(lds + F_TB);
    LAS unsigned* un = (LAS unsigned*)(lds + F_UN);
    LAS unsigned* selL = (LAS unsigned*)(lds + F_IMP) + (wave * 32 + ql) * 9;
    __syncthreads();
    build_t5(tb, P.in[15], 8 + h);
    if (MODE == M_SLC) { if (tid < 8) un[tid] = 0u; }
    __syncthreads();
    if (MODE == M_SLC) {
        const u32x4 a = *(const u32x4*)(selg + ((size_t)t * 2 + kvh) * 8), b = *(const u32x4*)(selg + ((size_t)t * 2 + kvh) * 8 + 4);
        if (g == 0) {
#pragma unroll
            for (int q = 0; q < 4; ++q) { atomicOr((unsigned*)(un + q), a[q]); atomicOr((unsigned*)(un + 4 + q), b[q]); selL[q] = a[q]; selL[4 + q] = b[q]; }
        }
        __syncthreads();
    }
    bf16x8 qf[8];
    load_q128(qf, z + Z1_NQ + ((size_t)h * S + t) * 128, g);
    f32x16 O[4];
#pragma unroll
    for (int i = 0; i < 4; ++i) O[i] = (f32x16)(0.f);
    float m = NEG, l = 0.f;
    const int tile_hi = (q0 + 255) >> 6;
    if (MODE == M_WIN) {
        const int lo = q0 >= 511 ? (q0 - 511) >> 6 : 0;
        flash_loop<M_WIN, 128, false>(lds, z + Z1_WK + (size_t)kvh * S * 128, 128, z + Z1_VT + (size_t)(1280 + kvh * 128) * S, S, nullptr,
                                      lo, tile_hi, qf, t, q0 + wave * 32, q0 + wave * 32 + 31, 0.08838834764831845f * LOG2E, tb, 0.f, O, m, l, nullptr);
    } else {
        flash_loop<M_SLC, 128, false>(lds, z + Z1_SK + (size_t)kvh * S * 128, 128, z + Z1_VT + (size_t)(1024 + kvh * 128) * S, S, nullptr,
                                      0, tile_hi, qf, t, q0 + wave * 32, q0 + wave * 32 + 31, 0.08838834764831845f * LOG2E, tb, 0.f, O, m, l, (LAS float*)selL);
    }
    l += __shfl_xor(l, 32);
    const float gate = gates[(size_t)t * 24 + (MODE == M_WIN ? 16 : 8) + h];
    const float sc = gate / l;
    const size_t ob = (size_t)t * 1024 + h * 128 + 4 * g;
    u32x2 cq[16], wq[16];
    if (MODE == M_SLC) {
#pragma unroll
        for (int i = 0; i < 16; ++i) { const size_t o = ob + (i >> 2) * 32 + (i & 3) * 8; cq[i] = *(const u32x2*)(ocmp + o); wq[i] = *(const u32x2*)(owin + o); }
    }
#pragma unroll
    for (int db = 0; db < 4; ++db)
#pragma unroll
        for (int r4 = 0; r4 < 4; ++r4) {
            f32x4 v; v[0] = O[db][r4 * 4] * sc; v[1] = O[db][r4 * 4 + 1] * sc; v[2] = O[db][r4 * 4 + 2] * sc; v[3] = O[db][r4 * 4 + 3] * sc;
            const size_t o = ob + db * 32 + r4 * 8;
            if (MODE == M_WIN) st_bf4(owin + o, v);
            else {
                const u32x2 c = cq[db * 4 + r4], w = wq[db * 4 + r4];
                v[0] += __uint_as_float(c[0] << 16) + __uint_as_float(w[0] << 16);
                v[1] += __uint_as_float(c[0] & 0xffff0000u) + __uint_as_float(w[0] & 0xffff0000u);
                v[2] += __uint_as_float(c[1] << 16) + __uint_as_float(w[1] << 16);
                v[3] += __uint_as_float(c[1] & 0xffff0000u) + __uint_as_float(w[1] & 0xffff0000u);
                st_bf4(mix + (size_t)t * DM + 1024 + h * 128 + 4 * g + db * 32 + r4 * 8, v);
            }
        }
}

__device__ __forceinline__ void cmp_item(CPR P, LAS unsigned char* lds, int kvh, int qt) {
    const bfraw* z = (const bfraw*)(P.ws + WS_Z);
    bfraw* ocmp = (bfraw*)(P.ws + WS_XB);
    const float* gates = (const float*)(P.ws + WS_GATES);
    unsigned* selg = (unsigned*)(P.ws + WS_SEL);
    const bfraw* kc = (const bfraw*)(P.ws + WS_KC) + (size_t)kvh * 1024 * 128;
    const bfraw* vct = (const bfraw*)(P.ws + WS_VCT) + (size_t)kvh * 128 * 1024;
    const int tid = otid(), wave = tid >> 6, lane = tid & 63, ql = lane & 31, g = lane >> 5;
    const int q0 = qt * 64, t = q0 + wave * 8 + (ql >> 2), r = ql & 3, h = kvh * 4 + r;
    LAS float* tb4 = (LAS float*)(lds + F_TB);
    LAS float* impw = (LAS float*)(lds + F_IMP) + wave * 2048;
    __syncthreads();
    {
        const int hh = tid >> 7, d = tid & 127;
        const float* table = P.in[15];
        tb4[hh * 132 + d] = (table[t5_bucket(d) * 16 + 8 + kvh * 4 + hh] - table[31 * 16 + 8 + kvh * 4 + hh]) * LOG2E;
        if (d == 0) tb4[hh * 132 + 128] = 0.f;
    }
#pragma unroll
    for (int i = 0; i < 32; ++i) impw[i * 64 + lane] = 0.f;
    __syncthreads();
    bf16x8 qf[8];
    load_q128(qf, z + Z1_NQ + ((size_t)h * S + t) * 128, g);
    f32x16 O[4];
#pragma unroll
    for (int i = 0; i < 4; ++i) O[i] = (f32x16)(0.f);
    float m = NEG, l = 0.f;
    const int tmax = q0 + 63;
    const int tile_hi = tmax >= 31 ? ((tmax - 31) >> 4) >> 6 : -1;
    const float sl2 = 0.08838834764831845f * LOG2E;
    flash_loop<M_CMP, 128, false>(lds, kc, 128, vct, 1024, nullptr, 0, tile_hi, qf, t, q0 + wave * 8, q0 + wave * 8 + 7, sl2, tb4 + r * 132, 0.f, O, m, l, nullptr);
    l += __shfl_xor(l, 32);
    const bool valid = m > -1e29f;
    const float inv = valid ? 1.0f / l : 0.f;
    {
        const float sc = inv * gates[(size_t)t * 24 + h];
        bfraw* orow = ocmp + (size_t)t * 1024 + h * 128 + 4 * g;
#pragma unroll
        for (int db = 0; db < 4; ++db)
#pragma unroll
            for (int r4 = 0; r4 < 4; ++r4) {
                f32x4 v; v[0] = O[db][r4 * 4] * sc; v[1] = O[db][r4 * 4 + 1] * sc; v[2] = O[db][r4 * 4 + 2] * sc; v[3] = O[db][r4 * 4 + 3] * sc;
                if (!valid) v = (f32x4){0.f, 0.f, 0.f, 0.f};
                st_bf4(orow + db * 32 + r4 * 8, v);
            }
    }
    float m2 = valid ? m : 0.f, l2 = inv;
    flash_loop<M_CMP, 128, true>(lds, kc, 128, vct, 1024, nullptr, 0, tile_hi, qf, t, q0 + wave * 8, q0 + wave * 8 + 7, sl2, tb4 + r * 132, 0.f, O, m2, l2, impw);
    __syncthreads();
    {
        float sc[8][4]; unsigned sel[8];
#pragma unroll
        for (int qi = 0; qi < 8; ++qi) {
            const int tq = q0 + wave * 8 + qi, cur = tq >> 6;
            sel[qi] = 0u;
#pragma unroll
            for (int i = 0; i < 4; ++i) {
                const int jb = i * 64 + lane;
                const float imp = impw[qi * 256 + jb];
                const bool forced = (jb == 0) || (jb == cur) || (jb == cur - 1);
                sc[qi][i] = forced ? 1e9f : ((jb * 64 <= tq) ? imp : -1e9f);
            }
        }
        for (int it = 0; it < 16; ++it) {
            float bv[8]; int bj[8];
#pragma unroll
            for (int qi = 0; qi < 8; ++qi) {
                bv[qi] = -3e38f; bj[qi] = 1 << 20;
#pragma unroll
                for (int i = 0; i < 4; ++i) if (!((sel[qi] >> i) & 1u) && sc[qi][i] > bv[qi]) { bv[qi] = sc[qi][i]; bj[qi] = i * 64 + lane; }
            }
#pragma unroll
            for (int qi = 0; qi < 8; ++qi) wave_argmax(bv[qi], bj[qi]);
#pragma unroll
            for (int qi = 0; qi < 8; ++qi) if ((bj[qi] & 63) == lane) sel[qi] |= 1u << (bj[qi] >> 6);
        }
#pragma unroll
        for (int qi = 0; qi < 8; ++qi) {
            const int tq = q0 + wave * 8 + qi;
            unsigned long long b0 = __builtin_amdgcn_ballot_w64((sel[qi] & 1u) != 0), b1 = __builtin_amdgcn_ballot_w64((sel[qi] & 2u) != 0),
                               b2 = __builtin_amdgcn_ballot_w64((sel[qi] & 4u) != 0), b3 = __builtin_amdgcn_ballot_w64((sel[qi] & 8u) != 0);
            if (lane < 8) {
                const unsigned long long bb = (lane >> 1) == 0 ? b0 : ((lane >> 1) == 1 ? b1 : ((lane >> 1) == 2 ? b2 : b3));
                selg[((size_t)tq * 2 + kvh) * 8 + lane] = (lane & 1) ? (unsigned)(bb >> 32) : (unsigned)bb;
            }
        }
    }
}

__device__ __forceinline__ void cmp_mlp_item(CPR P, LAS unsigned char* lds, int kv, int kvh, int mt) {
    const bfraw* z = (const bfraw*)(P.ws + WS_Z); const bfraw* W = (const bfraw*)(P.ws + WS_W);
    const bfraw* src = z + (kv == 0 ? Z1_CK : Z1_CV) + (size_t)kvh * CKV_HS;
    const bfraw* w1t = W + W_C1 + (size_t)kv * 128 * 4096; const bfraw* w2t = W + W_C2 + (size_t)kv * 128 * 128;
    const float* pbias = (const float*)(P.ws + WS_PBIAS) + kv * 128;
    const int tid = otid(), w = tid >> 6, lane = tid & 63, ql = lane & 31, g = lane >> 5;
    LAS unsigned char* As = lds; LAS unsigned char* Bs = lds + 128 * T128;
    f32x16 acc[2]; acc[0] = (f32x16)(0.f); acc[1] = (f32x16)(0.f);
    for (int kc = 0; kc < 32; ++kc) {
        __syncthreads();
        stage128(As, src + (size_t)(mt * 128) * 2048 + kc * 128, 2048);
        stage128(Bs, w1t + kc * 128, 4096);
        __syncthreads();
        mm128(As, T128, Bs, T128, 128, acc);
    }
    __syncthreads();
#pragma unroll
    for (int nb = 0; nb < 2; ++nb)
#pragma unroll
        for (int r = 0; r < 16; ++r) {
            const int row = (w >> 1) * 32 + (r & 3) + 8 * (r >> 2) + 4 * g, col = (w & 1) * 64 + nb * 32 + ql;
            *(LAS bfraw*)(As + row * T128 + col * 2) = f2bf(siluf_(acc[nb][r] + pbias[col]));
        }
    stage128(Bs, w2t, 128);
    __syncthreads();
    acc[0] = (f32x16)(0.f); acc[1] = (f32x16)(0.f);
    mm128(As, T128, Bs, T128, 128, acc);
    bfraw* kcb = (bfraw*)(P.ws + WS_KC) + (size_t)kvh * 1024 * 128; bfraw* vcb = (bfraw*)(P.ws + WS_VCT) + (size_t)kvh * 128 * 1024;
#pragma unroll
    for (int nb = 0; nb < 2; ++nb)
#pragma unroll
        for (int r = 0; r < 16; ++r) {
            const int row = mt * 128 + (w >> 1) * 32 + (r & 3) + 8 * (r >> 2) + 4 * g, col = (w & 1) * 64 + nb * 32 + ql;
            const bfraw v = row < 1023 ? f2bf(acc[nb][r]) : (bfraw)0;
            if (kv == 0) kcb[(size_t)row * 128 + col] = v; else vcb[(size_t)col * 1024 + row] = v;
        }
}

constexpr int N_PHASES = 19;
#ifndef PH_MASK
#define PH_MASK 0x1FFFFFFu
#endif
#define PHON(n) (((PH_MASK) >> (n)) & 1u)
__device__ __forceinline__ void grid_barrier(unsigned* ctr, unsigned k, unsigned G) {
    __syncthreads();
    if (threadIdx.x == 0) {
        __builtin_amdgcn_fence(__ATOMIC_RELEASE, "agent");
        asm volatile("s_waitcnt vmcnt(0) lgkmcnt(0)" ::: "memory");
        const unsigned grp = blockIdx.x & 7u, gsize = (G - grp + 7u) >> 3;
        const unsigned old = __hip_atomic_fetch_add(ctr + 32 * grp, 1u, __ATOMIC_RELAXED, __HIP_MEMORY_SCOPE_AGENT);
        if (old + 1u == gsize * k) __hip_atomic_fetch_add(ctr + 32 * 8, 1u, __ATOMIC_RELAXED, __HIP_MEMORY_SCOPE_AGENT);
        const unsigned ngrp = G < 8u ? G : 8u;
        while (__hip_atomic_load(ctr + 32 * 8, __ATOMIC_RELAXED, __HIP_MEMORY_SCOPE_AGENT) < ngrp * k) __builtin_amdgcn_s_sleep(4);
        __builtin_amdgcn_fence(__ATOMIC_ACQUIRE, "agent");
        asm volatile("s_waitcnt vmcnt(0) lgkmcnt(0)" ::: "memory");
    }
    __syncthreads();
}
__device__ __forceinline__ int queue_pop(unsigned* qctr, LAS unsigned char* lds) {
    LAS int* slot = (LAS int*)(lds + LDS_BYTES - 64);
    __syncthreads();
    if (otid() == 0) slot[0] = (int)__hip_atomic_fetch_add(qctr, 1u, __ATOMIC_RELAXED, __HIP_MEMORY_SCOPE_AGENT);
    __syncthreads();
    return __builtin_amdgcn_readfirstlane(slot[0]);
}
template <int ph>
__device__ __forceinline__ void run_phase(LAS unsigned char* lds, int G, int bid, unsigned* bar_ctr, unsigned& nbar) {
        const __attribute__((address_space(4))) Params* Pp = (const __attribute__((address_space(4))) Params*)__builtin_amdgcn_kernarg_segment_ptr();
        asm volatile("" : "+s"(Pp));
        CPR P = *Pp;
        bfraw* W = (bfraw*)(P.ws + WS_W);
        bfraw* XB = (bfraw*)(P.ws + WS_XB); bfraw* Z = (bfraw*)(P.ws + WS_Z); bfraw* Mx = (bfraw*)(P.ws + WS_M); bfraw* PB = (bfraw*)(P.ws + WS_PB);
        float* ssq = (float*)(P.ws + WS_SSQ);
        switch (ph) {
        case 0: if (PHON(0)) { phase_conv(P, lds, 0); phase_prep(P); } break;
        case 1: if (PHON(1)) {
            pg8::Gemm gm; gm.A0 = XB; gm.Bt0 = W + W_IN; gm.A1 = W + W_IN + (size_t)5376 * DM; gm.Bt1 = XB; gm.K = DM;
            pg8::Sched2 sc; sc.init(S, 5120, 2048, S, G, bid);
            EpiZ e{(const float*)(P.ws + WS_RINV), Z, (float*)(P.ws + WS_FL), 0};
            pg8::gemm_phase(lds, gm, sc, e);
            fl_rows(P, lds);
        } break;
        case 2: if (PHON(2)) {
            unsigned* qctr = (unsigned*)(P.ws + WS_BAR) + 386;
            for (;;) {
                const int it = queue_pop(qctr, lds);
                if (it >= 8 + 64 + 1024) break;
                if (it < 8) fox_cumsum_item(P, lds, it);
                else if (it < 72) fox_kmax_item(P, lds, (it - 8) & 7, (it - 8) >> 3);
                else ret_upd_item(P, lds, (it - 72) >> 7, (it - 72) & 127);
            }
            }
            break;
        case 3: if (PHON(3)) phase_ret_scan(P); break;
        case 4: if (PHON(4)) {
            unsigned* qctr = (unsigned*)(P.ws + WS_BAR) + 384;
            LAS int* slot = (LAS int*)(lds + LDS_BYTES - 64);
            for (;;) {
                __syncthreads();
                if (otid() == 0) slot[0] = (int)__hip_atomic_fetch_add(qctr, 1u, __ATOMIC_RELAXED, __HIP_MEMORY_SCOPE_AGENT);
                __syncthreads();
                const int it = __builtin_amdgcn_readfirstlane(slot[0]);
                if (it >= 512 + 1024) break;
                if (it < 512) { if (PHON(22)) fox_item(P, lds, it & 7, 63 - (it >> 3)); }
                else { const int r = it - 512; if (PHON(21)) ret_out_item(P, lds, r >> 7, r & 127); }
            }
            }
            break;
        case 5: case 14: if (PHON(5)) {
            pg8::Gemm gm; gm.A0 = Mx; gm.Bt0 = W + W_OUT; gm.A1 = Mx; gm.Bt1 = W + W_OUT; gm.K = DM;
            pg8::Sched2 sc; sc.init(S, DM, 0, 0, G, bid);
            EpiRes e{ph == 5 ? P.in[0] : P.out, P.out, XB, ssq, 1};
            pg8::gemm_phase(lds, gm, sc, e);
        } break;
        case 6: case 15: if (PHON(6)) {
            {
                const int gt = bid * NTHREADS + otid();
                if (gt < S) ((float*)(P.ws + WS_RINV))[gt] = row_rinv(ssq, gt);
                nbar += 1u; grid_barrier(bar_ctr, nbar, (unsigned)G);
            }
            if (PHON(23)) {
                pg8::Gemm gm; gm.A0 = XB; gm.Bt0 = W + W_GU; gm.A1 = XB; gm.Bt1 = W + W_GU; gm.K = DM;
                pg8::Sched2 sc; sc.init(S, 2 * DFF, 0, 0, G, bid);
                EpiGU e{(const float*)(P.ws + WS_RINV), Z};
                pg8::gemm_phase(lds, gm, sc, e);
            }
            if (PHON(24)) {
                const bfraw* pbl = PB + (size_t)(ph == 6 ? 0 : 1) * S * PLE;
                pg8::Gemm gm; gm.A0 = pbl; gm.Bt0 = W + W_PP; gm.A1 = pbl; gm.Bt1 = W + W_PP; gm.K = PLE;
                pg8::Sched2 sc; sc.init(S, DM, 0, 0, G, bid);
                EpiPP e{Mx};
                pg8::gemm_phase(lds, gm, sc, e);
            }
        } break;
        case 7: case 16: if (PHON(7)) {
            pg8::Gemm gm; gm.A0 = Z; gm.Bt0 = W + W_D; gm.A1 = Z; gm.Bt1 = W + W_D; gm.K = DFF;
            pg8::Sched2 sc; sc.init(S, DM, 0, 0, G, bid);
            EpiRes e{P.out, P.out, XB, ssq, 0};
            pg8::gemm_phase(lds, gm, sc, e);
        } break;
        case 8: case 17: if (PHON(8)) {
            pg8::Gemm gm; gm.A0 = XB; gm.Bt0 = W + W_PG; gm.A1 = XB; gm.Bt1 = W + W_PG; gm.K = DM;
            pg8::Sched2 sc; sc.init(S, DM, 0, 0, G, bid);
            EpiPLE e{P.out, Mx, ssq};
            pg8::gemm_phase(lds, gm, sc, e);
        } break;
        case 9: if (PHON(9)) phase_conv(P, lds, 1); break;
        case 10: if (PHON(10)) {
            pg8::Gemm gm; gm.A0 = Mx; gm.Bt0 = W + W_IN; gm.A1 = W + W_IN + (size_t)4352 * DM; gm.Bt1 = Mx; gm.K = DM;
            pg8::Sched2 sc; sc.init(S, 4352, 1536, S, G, bid);
            EpiZ e{(const float*)(P.ws + WS_RINV), Z, (float*)(P.ws + WS_GATES), 1};
            pg8::gemm_phase(lds, gm, sc, e);
        } break;
        case 11: {
            if (PHON(11)) for (int it = bid; it < 32; it += G) cmp_mlp_item(P, lds, it >> 4, (it >> 3) & 1, it & 7);
            if (PHON(19)) for (int u = bid * 2; u < 512; u += (u & 1) ? 2 * G - 1 : 1) { const int h = (u >> 1) & 7, pr = u >> 4; diff_item(P, lds, h, (u & 1) ? pr : 63 - pr); }
            if (PHON(20)) {
                const int skip = G > 64 ? 32 : 0;
                if (bid >= skip) for (int it = bid - skip; it < 512; it += G - skip) nsa_item<M_WIN>(P, lds, it & 7, it >> 3);
            }
            } break;
        case 12: if (PHON(12))
            for (int u = bid * 2; u < 512; u += (u & 1) ? 2 * G - 1 : 1) { const int kvh = (u >> 1) & 1, pr = u >> 2; cmp_item(P, lds, kvh, (u & 1) ? pr : 255 - pr); }
            break;
        case 13: if (PHON(13)) {
            unsigned* qctr = (unsigned*)(P.ws + WS_BAR) + 389;
            for (;;) {
                const int it = queue_pop(qctr, lds);
                if (it >= 512) break;
                nsa_item<M_SLC>(P, lds, it & 7, 63 - (it >> 3));
            }
            }
            break;
        case 18: if (PHON(18)) phase_final(P); break;
        default: break;
        }
}
#ifndef PROBE_REP
#define PROBE_REP 0u
#endif
#define GSYNC() do { nbar += 1u; grid_barrier(bar_ctr, nbar, (unsigned)G); } while (0)
#define RUN_PH(n) do { if ((n) >= ph_lo && (n) < ph_hi) { if ((n) != ph_lo) { GSYNC(); } run_phase<(n)>(lds, G, bid, bar_ctr, nbar); \
                       if ((PROBE_REP >> (n)) & 1u) { GSYNC(); run_phase<(n)>(lds, G, bid, bar_ctr, nbar); } } } while (0)
__global__ void __launch_bounds__(NTHREADS, 2) fwd_megakernel(Params P0) {
    extern __shared__ __attribute__((aligned(16))) unsigned char shm[];
    LAS unsigned char* lds = (LAS unsigned char*)shm;
    cg::grid_group grid = cg::this_grid();
    const int G = gridDim.x, bid = blockIdx.x;
    const int ph_lo = P0.ph_lo, ph_hi = P0.ph_hi;
    unsigned* bar_ctr = (unsigned*)(P0.ws + WS_BAR); unsigned nbar = 0u;
    if (ph_hi < 0) grid.sync();
    RUN_PH(0); RUN_PH(1); RUN_PH(2); RUN_PH(3); RUN_PH(4); RUN_PH(5); RUN_PH(6); RUN_PH(7); RUN_PH(8); RUN_PH(9);
    RUN_PH(10); RUN_PH(11); RUN_PH(12); RUN_PH(13); RUN_PH(14); RUN_PH(15); RUN_PH(16); RUN_PH(17); RUN_PH(18);
}

extern "C" void kernel_launch(void* const* d_in, const int* in_sizes, int n_in, void* d_out, int out_size, void* d_ws, size_t ws_size, hipStream_t stream) {
    static int grid_blocks = 0;
    if (!grid_blocks) {
        int dev = 0, cus = 0, per_cu = 0;
        hipGetDevice(&dev);
        hipDeviceGetAttribute(&cus, hipDeviceAttributeMultiprocessorCount, dev);
        hipFuncSetAttribute((const void*)fwd_megakernel, hipFuncAttributeMaxDynamicSharedMemorySize, LDS_BYTES);
        hipOccupancyMaxActiveBlocksPerMultiprocessor(&per_cu, (const void*)fwd_megakernel, NTHREADS, LDS_BYTES);
        if (per_cu < 1) per_cu = 1;
        grid_blocks = cus * 1;
        if (ws_size < WS_END) fprintf(stderr, "kernel_launch: workspace too small: %zu < %zu\n", ws_size, (size_t)WS_END);
        (void)hipGetLastError();
    }
    (void)hipMemsetAsync((char*)d_ws + WS_BAR, 0, 2048, stream);
    Params p{};
    for (int i = 0; i < 22 && i < n_in; ++i) p.in[i] = (const float*)d_in[i];
    p.out = (float*)d_out; p.ws = (unsigned char*)d_ws; p.ph_lo = 0; p.ph_hi = N_PHASES;
    void* args[] = {&p};
    hipError_t e = hipLaunchCooperativeKernel((const void*)fwd_megakernel, dim3(grid_blocks), dim3(NTHREADS), args, LDS_BYTES, stream);
    if (e != hipSuccess) fprintf(stderr, "cooperative launch failed: %s (grid %d)\n", hipGetErrorString(e), grid_blocks);
}
```

```cpp
#include <hip/hip_runtime.h>
#include <hip/hip_cooperative_groups.h>
#include <stdint.h>
#include <cstdio>
namespace cg = cooperative_groups;

#define LAS __attribute__((address_space(3)))
typedef unsigned short bfraw;
typedef short bf16x8 __attribute__((ext_vector_type(8)));
typedef float f32x4 __attribute__((ext_vector_type(4)));
typedef float f32x16 __attribute__((ext_vector_type(16)));
typedef unsigned u32x4 __attribute__((ext_vector_type(4)));
typedef unsigned u32x2 __attribute__((ext_vector_type(2)));

constexpr int S = 16384, DM = 2048, DFF = 5632, PLE = 256;
constexpr int EVEN_COLS = 7176, ODD_COLS = 5656;
constexpr float EPS = 1e-6f;
constexpr float LOG2E = 1.4426950408889634f;
constexpr float NEG = -1e30f;
constexpr float LINIT = 0.35550906759096934f;
constexpr int NTHREADS = 512;
constexpr int LDS_BYTES = 147456;

constexpr size_t WS_W = 0;
constexpr size_t W_IN = 0, W_OUT = 15204352, W_GU = 19398656, W_D = 42467328, W_PG = 54001664, W_PP = 58195968, W_C1 = 58720256, W_C2 = 59768832, W_END = 59801600;
constexpr size_t WS_XB = WS_W + W_END * 2;
constexpr size_t WS_Z = WS_XB + (size_t)S * DM * 2;
constexpr size_t WS_M = WS_Z + (size_t)S * 7168 * 2;
constexpr size_t WS_PB = WS_M + (size_t)S * DM * 2;
constexpr size_t WS_SSQ = WS_PB + (size_t)2 * S * PLE * 2;
constexpr size_t WS_FL = WS_SSQ + (size_t)S * 32 * 4;
constexpr size_t WS_C2 = WS_FL + (size_t)8 * S * 4;
constexpr size_t WS_GATES = WS_C2 + (size_t)8 * S * 4;
constexpr size_t WS_SEL = WS_GATES + (size_t)S * 24 * 4;
constexpr size_t WS_KC = WS_SEL + (size_t)S * 16 * 4;
constexpr size_t WS_VCT = WS_KC + (size_t)2 * 1024 * 128 * 2;
constexpr size_t WS_PBIAS = WS_VCT + (size_t)2 * 1024 * 128 * 2;
constexpr size_t WS_KMAX = WS_PBIAS + 2048;
constexpr size_t WS_BAR = WS_PBIAS + 4096;
constexpr size_t WS_RINV = WS_PBIAS + 8192;
constexpr size_t WS_END = WS_RINV + (size_t)S * 4;
constexpr size_t Z0_RQK = 0, Z0_RG = (size_t)2048 * S, Z0_FQK = (size_t)3072 * S, Z0_VT = (size_t)5120 * S;
constexpr size_t CKV_HS = (size_t)(S + 32) * 128;
constexpr size_t Z1_DQK = 0, Z1_NQ = (size_t)2048 * S, Z1_CK = (size_t)3072 * S, Z1_CV = Z1_CK + 2 * CKV_HS, Z1_SK = Z1_CV + 2 * CKV_HS,
                 Z1_WK = Z1_SK + (size_t)256 * S, Z1_VT = Z1_WK + (size_t)256 * S;

struct Params {
    const float* in[22];
    float* out;
    unsigned char* ws;
    int ph_lo, ph_hi;
};

typedef const __attribute__((address_space(4))) Params& CPR;
__device__ __forceinline__ int otid() { int t = threadIdx.x; asm volatile("" : "+v"(t)); return t; }
__device__ __forceinline__ unsigned short f2bf(float f) { unsigned u = __float_as_uint(f); u += 0x7fffu + ((u >> 16) & 1u); return (unsigned short)(u >> 16); }
__device__ __forceinline__ float bf2f(unsigned short b) { return __uint_as_float(((unsigned)b) << 16); }
__device__ __forceinline__ unsigned pack2(float lo, float hi) { unsigned r; asm volatile("v_cvt_pk_bf16_f32 %0, %1, %2" : "=v"(r) : "v"(lo), "v"(hi)); return r; }
__device__ __forceinline__ float fexp2(float x) { return __builtin_amdgcn_exp2f(x); }
template <int CTRL> __device__ __forceinline__ int dppi(int v) { return __builtin_amdgcn_update_dpp(v, v, CTRL, 0xF, 0xF, false); }
template <int CTRL> __device__ __forceinline__ float dppf(float v) { return __int_as_float(dppi<CTRL>(__float_as_int(v))); }
__device__ __forceinline__ void amax_merge(float& bv, int& bj, float ov, int oj) { if (ov > bv || (ov == bv && oj < bj)) { bv = ov; bj = oj; } }
__device__ __forceinline__ void wave_argmax(float& bv, int& bj) {
    typedef unsigned u2v __attribute__((ext_vector_type(2)));
    amax_merge(bv, bj, dppf<0xB1>(bv), dppi<0xB1>(bj));
    amax_merge(bv, bj, dppf<0x4E>(bv), dppi<0x4E>(bj));
    amax_merge(bv, bj, dppf<0x141>(bv), dppi<0x141>(bj));
    amax_merge(bv, bj, dppf<0x140>(bv), dppi<0x140>(bj));
    {
        const u2v rv = __builtin_amdgcn_permlane16_swap(__float_as_uint(bv), __float_as_uint(bv), false, false);
        const u2v rj = __builtin_amdgcn_permlane16_swap((unsigned)bj, (unsigned)bj, false, false);
        float av = __uint_as_float(rv[0]); int aj = (int)rj[0];
        amax_merge(av, aj, __uint_as_float(rv[1]), (int)rj[1]); bv = av; bj = aj;
    }
    {
        const u2v rv = __builtin_amdgcn_permlane32_swap(__float_as_uint(bv), __float_as_uint(bv), false, false);
        const u2v rj = __builtin_amdgcn_permlane32_swap((unsigned)bj, (unsigned)bj, false, false);
        float av = __uint_as_float(rv[0]); int aj = (int)rj[0];
        amax_merge(av, aj, __uint_as_float(rv[1]), (int)rj[1]); bv = av; bj = aj;
    }
}
__device__ __forceinline__ float xhalf_max(float x) {
    typedef unsigned u2v __attribute__((ext_vector_type(2)));
    const u2v r = __builtin_amdgcn_permlane32_swap(__float_as_uint(x), __float_as_uint(x), false, false);
    return fmaxf(__uint_as_float(r[0]), __uint_as_float(r[1]));
}
__device__ __forceinline__ float fmax3(float a, float b, float c) { float d; asm("v_max3_f32 %0, %1, %2, %3" : "=v"(d) : "v"(a), "v"(b), "v"(c)); return d; }
__device__ __forceinline__ float sigmoidf_(float x) { return __builtin_amdgcn_rcpf(1.0f + fexp2(-LOG2E * x)); }
__device__ __forceinline__ float siluf_(float x) { return x * __builtin_amdgcn_rcpf(1.0f + fexp2(-LOG2E * x)); }
__device__ __forceinline__ float wsum(float v) {
#pragma unroll
    for (int o = 32; o >= 1; o >>= 1) v += __shfl_xor(v, o);
    return v;
}
__device__ __forceinline__ float row_rinv(const float* ssq, int row) {
    const f32x4* p = (const f32x4*)(ssq + (size_t)row * 32);
    float s = 0.f;
#pragma unroll
    for (int i = 0; i < 8; ++i) { f32x4 v = p[i]; s += (v[0] + v[1]) + (v[2] + v[3]); }
    return rsqrtf(s * (1.0f / 2048.0f) + EPS);
}

namespace pg8 {
constexpr int BM = 256, BK = 64, HALF = 128, HTB = HALF * BK * 2, STAGE_BYTES = 8 * HTB, NXCD = 8, WGM = 8;
__device__ __forceinline__ int lds_byte(int r, int c) { const int st = (r >> 4) * 2 + (c >> 5), rr = r & 15, cc = c & 31, ob = rr * 64 + cc * 2; return st * 1024 + (ob ^ (((ob >> 9) & 1) << 5)); }
__device__ __forceinline__ void stage_rc(int b, int& R, int& C) { const int st = b / 1024, sb = b % 1024, swz = sb ^ (((sb >> 9) & 1) << 5); R = (st >> 1) * 16 + swz / 64; C = (st & 1) * 32 + (swz % 64) / 2; }
struct Unit { int pm, pn, job; };
struct Gemm { const bfraw* A0; const bfraw* A1; const bfraw* Bt0; const bfraw* Bt1; int K; };
struct Sched2 {
    int nM[2], nN[2], nwg[2], G, c;
    __device__ void init(int M0, int N0, int M1, int N1, int G_, int c_) { nM[0] = M0 / BM; nN[0] = N0 / BM; nwg[0] = nM[0] * nN[0]; nM[1] = M1 / BM; nN[1] = N1 / BM; nwg[1] = nM[1] * nN[1]; G = G_; c = c_; }
    __device__ __forceinline__ void map(int wgid, int j, Unit& u) const {
        const int nwgj = nwg[j], nMj = nM[j], nNj = nN[j];
        { const int q = nwgj / NXCD, r = nwgj % NXCD, xcd = wgid % NXCD, off = wgid / NXCD; wgid = (xcd < r ? xcd * (q + 1) : r * (q + 1) + (xcd - r) * q) + off; }
        const int nig = WGM * nNj, gid = wgid / nig, fm = gid * WGM, gsz = (nMj - fm) < WGM ? (nMj - fm) : WGM;
        u.pm = fm + ((wgid % nig) % gsz); u.pn = (wgid % nig) / gsz; u.job = j;
    }
    __device__ __forceinline__ bool next(int i, Unit& u) const {
        long L = (long)i * G + c;
        if (L < nwg[0]) { map((int)L, 0, u); return true; }
        L -= nwg[0];
        if (L < nwg[1]) { map((int)L, 1, u); return true; }
        return false;
    }
};

template <class Epi>
__device__ __forceinline__ void gemm_phase(LAS unsigned char* lds, const Gemm g, const Sched2& S_, const Epi& E) {
    const int tid = otid(), wid = __builtin_amdgcn_readfirstlane(tid >> 6), lane = tid & 63, wr = wid >> 2, wc = wid & 3, fr = lane & 15, fq = lane >> 4;
    const int K = g.K, nt = K / BK;
    unsigned voffA[2], voffB[2];
#pragma unroll
    for (int i = 0; i < 2; ++i) { int R, C; stage_rc(tid * 16 + i * 8192, R, C); voffA[i] = (unsigned)(R * K + C) * 2u; voffB[i] = voffA[i]; }
    const size_t kstep = (size_t)(BK * 2);
    const size_t hstep = (size_t)HALF * K * 2;
    const size_t tstep = 2 * hstep;
    const unsigned ldsw = (unsigned)wid * 1024u;
    const int aoff = lds_byte(wr * 64 + fr, fq * 8), boff = lds_byte(wc * 32 + fr, fq * 8);
#define PG8_SA(b, h) (((b) * 2 + (h)) * HTB)
#define PG8_SB(b, h) ((4 + (b) * 2 + (h)) * HTB)
#define PG8_STAGE(bufoff, gbase, voff) do { _Pragma("unroll") for (int _i = 0; _i < 2; ++_i) \
        __builtin_amdgcn_global_load_lds((const unsigned*)((const char*)(gbase) + (voff)[_i]), (LAS unsigned*)(lds + (bufoff) + ldsw + _i * 8192), 16, 0, 0); } while (0)
#define PG8_LDA(dst, b, h) do { _Pragma("unroll") for (int m = 0; m < 4; ++m) _Pragma("unroll") for (int k = 0; k < 2; ++k) dst[m][k] = *(const LAS bf16x8*)(lds + PG8_SA(b, h) + aoff + m * 2048 + k * 1024); } while (0)
#define PG8_LDB(dst, b, h) do { _Pragma("unroll") for (int n = 0; n < 2; ++n) _Pragma("unroll") for (int k = 0; k < 2; ++k) dst[n][k] = *(const LAS bf16x8*)(lds + PG8_SB(b, h) + boff + n * 2048 + k * 1024); } while (0)
#define PG8_MMA(ai, bj, At, Bt) do { __builtin_amdgcn_s_setprio(1); _Pragma("unroll") for (int m = 0; m < 4; ++m) _Pragma("unroll") for (int n = 0; n < 2; ++n) _Pragma("unroll") for (int k = 0; k < 2; ++k) \
        acc[ai][bj][m][n] = __builtin_amdgcn_mfma_f32_16x16x32_bf16(Bt[n][k], At[m][k], acc[ai][bj][m][n], 0, 0, 0); __builtin_amdgcn_s_setprio(0); } while (0)
#define PG8_WAIT_V(n) asm volatile("s_waitcnt vmcnt(" #n ")" ::: "memory")
#define PG8_WAIT_L(n) asm volatile("s_waitcnt lgkmcnt(" #n ")" ::: "memory")
#define PG8_BAR __builtin_amdgcn_s_barrier()
#define PG8_SCHED __builtin_amdgcn_sched_barrier(0)
    Unit cur, nxt; int ui = 0;
    if (!S_.next(0, cur)) return;
    f32x4 acc[2][2][4][2];
#pragma unroll
    for (int a = 0; a < 2; ++a)
#pragma unroll
        for (int b = 0; b < 2; ++b)
#pragma unroll
            for (int m = 0; m < 4; ++m)
#pragma unroll
                for (int n = 0; n < 2; ++n) acc[a][b][m][n] = (f32x4){0.f, 0.f, 0.f, 0.f};
    bf16x8 At[4][2], B0[2][2], B1[2][2];
    const char* cA = (const char*)(cur.job ? g.A1 : g.A0) + (size_t)cur.pm * tstep; const char* cB = (const char*)(cur.job ? g.Bt1 : g.Bt0) + (size_t)cur.pn * tstep;
    PG8_STAGE(PG8_SB(0, 0), cB, voffB); PG8_STAGE(PG8_SA(0, 0), cA, voffA); PG8_STAGE(PG8_SB(0, 1), cB + hstep, voffB); PG8_STAGE(PG8_SA(0, 1), cA + hstep, voffA);
    if (wr == 1) PG8_BAR;
    PG8_WAIT_V(4); PG8_BAR;
    PG8_STAGE(PG8_SB(1, 0), cB + kstep, voffB); PG8_STAGE(PG8_SA(1, 0), cA + kstep, voffA); PG8_STAGE(PG8_SB(1, 1), cB + hstep + kstep, voffB);
    PG8_WAIT_V(6); PG8_BAR;
    for (;;) {
        const bool has_next = S_.next(ui + 1, nxt);
        const char* nA = has_next ? (const char*)(nxt.job ? g.A1 : g.A0) + (size_t)nxt.pm * tstep : cA; const char* nB = has_next ? (const char*)(nxt.job ? g.Bt1 : g.Bt0) + (size_t)nxt.pn * tstep : cB;
        for (int t = 0; t < nt; t += 2) {
            const bool last = (t == nt - 2);
            const char* a1 = cA + (size_t)(t + 1) * kstep;
            const char* a2 = last ? nA : cA + (size_t)(t + 2) * kstep; const char* b2 = last ? nB : cB + (size_t)(t + 2) * kstep;
            const char* a3 = a2 + kstep; const char* b3 = b2 + kstep;
            PG8_LDB(B0, 0, 0); PG8_SCHED; PG8_LDA(At, 0, 0); PG8_STAGE(PG8_SA(1, 1), a1 + hstep, voffA);
            PG8_WAIT_L(8); PG8_BAR; PG8_WAIT_L(0); PG8_MMA(0, 0, At, B0); PG8_BAR; PG8_SCHED;
            PG8_LDB(B1, 0, 1); PG8_STAGE(PG8_SB(0, 0), b2, voffB);
            PG8_BAR; PG8_WAIT_L(0); PG8_MMA(0, 1, At, B1); PG8_BAR;
            PG8_LDA(At, 0, 1); PG8_STAGE(PG8_SA(0, 0), a2, voffA);
            PG8_BAR; PG8_WAIT_L(0); PG8_MMA(1, 0, At, B0); PG8_BAR; PG8_SCHED;
            PG8_STAGE(PG8_SB(0, 1), b2 + hstep, voffB);
            PG8_WAIT_V(6); PG8_BAR; PG8_MMA(1, 1, At, B1); PG8_BAR;
            PG8_LDB(B0, 1, 0); PG8_SCHED; PG8_LDA(At, 1, 0); PG8_STAGE(PG8_SA(0, 1), a2 + hstep, voffA);
            PG8_WAIT_L(8); PG8_BAR; PG8_WAIT_L(0); PG8_MMA(0, 0, At, B0); PG8_BAR; PG8_SCHED;
            PG8_LDB(B1, 1, 1); PG8_STAGE(PG8_SB(1, 0), b3, voffB);
            PG8_BAR; PG8_WAIT_L(0); PG8_MMA(0, 1, At, B1); PG8_BAR;
            PG8_LDA(At, 1, 1); PG8_STAGE(PG8_SA(1, 0), a3, voffA);
            PG8_BAR; PG8_WAIT_L(0); PG8_MMA(1, 0, At, B0); PG8_BAR; PG8_SCHED;
            PG8_STAGE(PG8_SB(1, 1), b3 + hstep, voffB);
            PG8_WAIT_V(6); PG8_BAR; PG8_MMA(1, 1, At, B1); PG8_BAR;
        }
        E(acc, cur, wr, wc, fr, fq);
        if (!has_next) break;
#pragma unroll
        for (int a = 0; a < 2; ++a)
#pragma unroll
            for (int b = 0; b < 2; ++b)
#pragma unroll
                for (int m = 0; m < 4; ++m)
#pragma unroll
                    for (int n = 0; n < 2; ++n) acc[a][b][m][n] = (f32x4){0.f, 0.f, 0.f, 0.f};
        cur = nxt; cA = nA; cB = nB; ++ui;
    }
    PG8_WAIT_V(0);
    if (wr == 0) PG8_BAR;
    PG8_BAR;
#undef PG8_SA
#undef PG8_SB
#undef PG8_STAGE
#undef PG8_LDA
#undef PG8_LDB
#undef PG8_MMA
#undef PG8_WAIT_V
#undef PG8_WAIT_L
#undef PG8_BAR
#undef PG8_SCHED
}
}
using pg8::Unit;
typedef f32x4 AccT[2][2][4][2];

__device__ __forceinline__ void st_bf4(bfraw* p, f32x4 v) { u32x2 o; o[0] = pack2(v[0], v[1]); o[1] = pack2(v[2], v[3]); *(u32x2*)p = o; }

struct EpiZ {
    const float* ssq; bfraw* z; float* aux; int layer;
    __device__ __forceinline__ void operator()(const AccT& acc, const Unit& u, int wr, int wc, int fr, int fq) const {
        if (u.job == 0) {
            size_t base; int c0, gc; size_t hs; int kind = 0;
            const int pn = u.pn;
            if (layer == 0) {
                if (pn < 8) { base = Z0_RQK; c0 = 0; gc = 128; hs = (size_t)S * 128; }
                else if (pn < 12) { base = Z0_RG; c0 = 2048; gc = 1024; hs = 0; }
                else if (pn < 20) { base = Z0_FQK; c0 = 3072; gc = 128; hs = (size_t)S * 128; }
                else { base = 0; c0 = 5120; gc = 1; hs = 0; kind = 1; }
            } else {
                if (pn < 8) { base = Z1_DQK; c0 = 0; gc = 64; hs = (size_t)S * 64; }
                else if (pn < 12) { base = Z1_NQ; c0 = 2048; gc = 128; hs = (size_t)S * 128; }
                else if (pn == 12) { base = Z1_CK; c0 = 3072; gc = 128; hs = CKV_HS; }
                else if (pn == 13) { base = Z1_CV; c0 = 3328; gc = 128; hs = CKV_HS; }
                else if (pn == 14) { base = Z1_SK; c0 = 3584; gc = 128; hs = (size_t)S * 128; }
                else if (pn == 15) { base = Z1_WK; c0 = 3840; gc = 128; hs = (size_t)S * 128; }
                else { base = 0; c0 = 4096; gc = 1; hs = 0; kind = 2; }
            }
            const int gsh = 31 - __builtin_clz((unsigned)gc);
#pragma unroll
            for (int ai = 0; ai < 2; ++ai) {
                float ri4[4];
#pragma unroll
                for (int m = 0; m < 4; ++m) ri4[m] = ssq[u.pm * 256 + ai * 128 + wr * 64 + m * 16 + fr];
#pragma unroll
                for (int m = 0; m < 4; ++m) {
                    const int row = u.pm * 256 + ai * 128 + wr * 64 + m * 16 + fr;
                    const float ri = ri4[m];
#pragma unroll
                    for (int bj = 0; bj < 2; ++bj)
#pragma unroll
                        for (int n = 0; n < 2; ++n) {
                            const int col = pn * 256 + bj * 128 + wc * 32 + n * 16 + fq * 4;
                            f32x4 v = acc[ai][bj][m][n] * ri;
                            const int cl = col - c0;
                            if (kind == 0) {
                                st_bf4(z + base + (size_t)(cl >> gsh) * hs + ((size_t)row << gsh) + (cl & (gc - 1)), v);
                            } else if (kind == 1) {
                                if (cl < 8) {
#pragma unroll
                                    for (int j = 0; j < 4; ++j) aux[(size_t)(cl + j) * S + row] = v[j];
                                }
                            } else {
                                if (cl < 24) {
#pragma unroll
                                    for (int j = 0; j < 4; ++j) aux[(size_t)row * 24 + cl + j] = sigmoidf_(v[j]);
                                }
                            }
                        }
                }
            }
        } else {
            bfraw* vt = z + (layer == 0 ? Z0_VT : Z1_VT);
            f32x4 rq4[4];
#pragma unroll
            for (int q = 0; q < 4; ++q) rq4[q] = *(const f32x4*)(ssq + u.pn * 256 + (q >> 1) * 128 + wc * 32 + (q & 1) * 16 + fq * 4);
#pragma unroll
            for (int bj = 0; bj < 2; ++bj)
#pragma unroll
                for (int n = 0; n < 2; ++n) {
                    const int col = u.pn * 256 + bj * 128 + wc * 32 + n * 16 + fq * 4;
                    const f32x4 ri = rq4[bj * 2 + n];
#pragma unroll
                    for (int ai = 0; ai < 2; ++ai)
#pragma unroll
                        for (int m = 0; m < 4; ++m) {
                            const int row = u.pm * 256 + ai * 128 + wr * 64 + m * 16 + fr;
                            st_bf4(vt + (size_t)row * S + col, acc[ai][bj][m][n] * ri);
                        }
                }
        }
    }
};

struct EpiRes {
    const float* xin; float* xout; bfraw* xb; float* ssq; int want_ssq;
    __device__ __forceinline__ void operator()(const AccT& acc, const Unit& u, int wr, int wc, int fr, int fq) const {
        const int row_b = u.pm * 256 + wr * 64 + fr, col_b = u.pn * 256 + wc * 32 + fq * 4;
        f32x4 xv[2][4];
#pragma unroll
        for (int q = 0; q < 4; ++q) xv[0][q] = *(const f32x4*)(xin + (size_t)row_b * DM + col_b + (q >> 1) * 128 + (q & 1) * 16);
#pragma unroll
        for (int bt = 0; bt < 8; ++bt) {
            const int ai = bt >> 2, m = bt & 3;
            const int row = row_b + ai * 128 + m * 16;
            if (bt + 1 < 8) {
                const int rown = row_b + ((bt + 1) >> 2) * 128 + ((bt + 1) & 3) * 16;
#pragma unroll
                for (int q = 0; q < 4; ++q) xv[(bt + 1) & 1][q] = *(const f32x4*)(xin + (size_t)rown * DM + col_b + (q >> 1) * 128 + (q & 1) * 16);
            }
            float part = 0.f;
#pragma unroll
            for (int q = 0; q < 4; ++q) {
                const int bj = q >> 1, n = q & 1;
                const size_t o = (size_t)row * DM + col_b + bj * 128 + n * 16;
                f32x4 v = xv[bt & 1][q] + acc[ai][bj][m][n];
                *(f32x4*)(xout + o) = v;
                st_bf4(xb + o, v);
                part += (v[0] * v[0] + v[1] * v[1]) + (v[2] * v[2] + v[3] * v[3]);
            }
            if (want_ssq) {
                part += __shfl_xor(part, 16); part += __shfl_xor(part, 32);
                if (fq == 0) ssq[(size_t)row * 32 + u.pn * 4 + wc] = part;
            }
        }
    }
};
struct EpiGU {
    const float* ssq; bfraw* act;
    __device__ __forceinline__ void operator()(const AccT& acc, const Unit& u, int wr, int wc, int fr, int fq) const {
#pragma unroll
        for (int ai = 0; ai < 2; ++ai) {
            float ri4[4];
#pragma unroll
            for (int m = 0; m < 4; ++m) ri4[m] = ssq[u.pm * 256 + ai * 128 + wr * 64 + m * 16 + fr];
#pragma unroll
            for (int m = 0; m < 4; ++m) {
                const int row = u.pm * 256 + ai * 128 + wr * 64 + m * 16 + fr;
                const float ri = ri4[m];
#pragma unroll
                for (int n = 0; n < 2; ++n) {
                    const int col = u.pn * 128 + wc * 32 + n * 16 + fq * 4;
                    f32x4 gt = acc[ai][0][m][n] * ri, up = acc[ai][1][m][n] * ri, r;
#pragma unroll
                    for (int j = 0; j < 4; ++j) r[j] = siluf_(gt[j]) * up[j];
                    st_bf4(act + (size_t)row * DFF + col, r);
                }
            }
        }
    }
};
struct EpiPP {
    bfraw* pp;
    __device__ __forceinline__ void operator()(const AccT& acc, const Unit& u, int wr, int wc, int fr, int fq) const {
#pragma unroll
        for (int ai = 0; ai < 2; ++ai)
#pragma unroll
            for (int m = 0; m < 4; ++m) {
                const int row = u.pm * 256 + ai * 128 + wr * 64 + m * 16 + fr;
#pragma unroll
                for (int bj = 0; bj < 2; ++bj)
#pragma unroll
                    for (int n = 0; n < 2; ++n) {
                        const int col = u.pn * 256 + bj * 128 + wc * 32 + n * 16 + fq * 4;
                        {
                            const f32x4 v = acc[ai][bj][m][n]; u32x2 o;
                            o[0] = (unsigned)f2bf(v[0]) | ((unsigned)f2bf(v[1]) << 16); o[1] = (unsigned)f2bf(v[2]) | ((unsigned)f2bf(v[3]) << 16);
                            *(u32x2*)(pp + (size_t)row * DM + col) = o;
                        }
                    }
            }
    }
};
struct EpiPLE {
    float* x; bfraw* pp; float* ssq;
    __device__ __forceinline__ void operator()(const AccT& acc, const Unit& u, int wr, int wc, int fr, int fq) const {
        const int row_b = u.pm * 256 + wr * 64 + fr, col_b = u.pn * 256 + wc * 32 + fq * 4;
#pragma unroll
        for (int bt = 0; bt < 8; ++bt) {
            const int ai = bt >> 2, m = bt & 3;
            const int row = row_b + ai * 128 + m * 16;
            f32x4 xv[4]; u32x2 pr[4];
#pragma unroll
            for (int q = 0; q < 4; ++q) {
                const size_t o = (size_t)row * DM + col_b + (q >> 1) * 128 + (q & 1) * 16;
                xv[q] = *(const f32x4*)(x + o); pr[q] = *(const u32x2*)(pp + o);
            }
            float part = 0.f;
#pragma unroll
            for (int q = 0; q < 4; ++q) {
                const int bj = q >> 1, n = q & 1;
                const size_t o = (size_t)row * DM + col_b + bj * 128 + n * 16;
                const f32x4 a = acc[ai][bj][m][n]; f32x4 v;
                v[0] = xv[q][0] + sigmoidf_(a[0]) * __uint_as_float(pr[q][0] << 16);
                v[1] = xv[q][1] + sigmoidf_(a[1]) * __uint_as_float(pr[q][0] & 0xffff0000u);
                v[2] = xv[q][2] + sigmoidf_(a[2]) * __uint_as_float(pr[q][1] << 16);
                v[3] = xv[q][3] + sigmoidf_(a[3]) * __uint_as_float(pr[q][1] & 0xffff0000u);
                *(f32x4*)(x + o) = v;
                st_bf4(pp + o, v);
                part += (v[0] * v[0] + v[1] * v[1]) + (v[2] * v[2] + v[3] * v[3]);
            }
            part += __shfl_xor(part, 16); part += __shfl_xor(part, 32);
            if (fq == 0) ssq[(size_t)row * 32 + u.pn * 4 + wc] = part;
        }
    }
};

__device__ __forceinline__ void conv_mat(LAS unsigned char* lds, const float* src, int ld_src, int K, int ncols, int ncols_pad, bfraw* dst, const float* gain, int blk, int off) {
    const int tid = otid();
    const int nk = K / 64, nn = ncols_pad / 64, ntiles = nk * nn, G = gridDim.x;
    const int lkk = tid >> 4, ln = (tid & 15) * 4;
    const int sn = tid >> 3, skg = tid & 7;
    f32x4 cur[2][2], nxt[2][2];
    auto load = [&](int t, f32x4 (&r)[2]) {
        const int k0 = (t % nk) * 64, n0 = (t / nk) * 64;
#pragma unroll
        for (int i = 0; i < 2; ++i) {
            const int kk = lkk + i * 32;
            f32x4 v = (f32x4){0.f, 0.f, 0.f, 0.f};
            if (t < ntiles && n0 + ln + 3 < ncols) { v = *(const f32x4*)(src + (size_t)(k0 + kk) * ld_src + n0 + ln); if (gain) v = v * gain[k0 + kk]; }
            r[i] = v;
        }
    };
    int t = blockIdx.x;
    if (t < ntiles) { load(t, cur[0]); load(t + G, cur[1]); }
    for (; t < ntiles; t += 2 * G) {
        const int tn = t + 2 * G;
        if (tn < ntiles) { load(tn, nxt[0]); load(tn + G, nxt[1]); }
        __syncthreads();
#pragma unroll
        for (int u = 0; u < 2; ++u) {
            LAS float* tile = (LAS float*)lds + u * (64 * 65);
#pragma unroll
            for (int i = 0; i < 2; ++i)
#pragma unroll
                for (int j = 0; j < 4; ++j) tile[(lkk + i * 32) * 65 + ln + j] = cur[u][i][j];
        }
        __syncthreads();
#pragma unroll
        for (int u = 0; u < 2; ++u) {
            const int tt = t + u * G;
            if (tt < ntiles) {
                const LAS float* tile = (const LAS float*)lds + u * (64 * 65);
                const int k0 = (tt % nk) * 64, n0 = (tt / nk) * 64;
                const int nglob = n0 + sn;
                const int drow = blk ? (nglob / blk) * (2 * blk) + off + (nglob % blk) : nglob;
                u32x4 o;
#pragma unroll
                for (int j = 0; j < 4; ++j) o[j] = pack2(tile[(skg * 8 + 2 * j) * 65 + sn], tile[(skg * 8 + 2 * j + 1) * 65 + sn]);
                *(u32x4*)(dst + (size_t)drow * K + k0 + skg * 8) = o;
            }
        }
#pragma unroll
        for (int u = 0; u < 2; ++u) { cur[u][0] = nxt[u][0]; cur[u][1] = nxt[u][1]; }
    }
    __syncthreads();
}

__device__ __forceinline__ void phase_conv(CPR P, LAS unsigned char* lds, int layer) {
    bfraw* W = (bfraw*)(P.ws + WS_W);
    const float* nm = P.in[2] + layer * DM; const float* nf = P.in[3] + layer * DM;
    if (layer == 0) {
        const float* wi = P.in[4];
        conv_mat(lds, wi + 0, EVEN_COLS, DM, 2048, 2048, W + W_IN, nm, 0, 0);
        conv_mat(lds, wi + 3072, EVEN_COLS, DM, 3072, 3072, W + W_IN + (size_t)2048 * DM, nm, 0, 0);
        conv_mat(lds, wi + 7168, EVEN_COLS, DM, 8, 256, W + W_IN + (size_t)5120 * DM, nm, 0, 0);
        conv_mat(lds, wi + 2048, EVEN_COLS, DM, 1024, 1024, W + W_IN + (size_t)5376 * DM, nm, 0, 0);
        conv_mat(lds, wi + 6144, EVEN_COLS, DM, 1024, 1024, W + W_IN + (size_t)6400 * DM, nm, 0, 0);
        conv_mat(lds, P.in[7], DM, DM, DM, DM, W + W_OUT, nullptr, 0, 0);
    } else {
        const float* wi = P.in[8];
        conv_mat(lds, wi + 0, ODD_COLS, DM, 2048, 2048, W + W_IN, nm, 0, 0);
        conv_mat(lds, wi + 3072, ODD_COLS, DM, 1792, 1792, W + W_IN + (size_t)2048 * DM, nm, 0, 0);
        conv_mat(lds, wi + 5120, ODD_COLS, DM, 256, 256, W + W_IN + (size_t)3840 * DM, nm, 0, 0);
        conv_mat(lds, wi + 5632, ODD_COLS, DM, 24, 256, W + W_IN + (size_t)4096 * DM, nm, 0, 0);
        conv_mat(lds, wi + 2048, ODD_COLS, DM, 1024, 1024, W + W_IN + (size_t)4352 * DM, nm, 0, 0);
        conv_mat(lds, wi + 4864, ODD_COLS, DM, 256, 256, W + W_IN + (size_t)5376 * DM, nm, 0, 0);
        conv_mat(lds, wi + 5376, ODD_COLS, DM, 256, 256, W + W_IN + (size_t)5632 * DM, nm, 0, 0);
        conv_mat(lds, P.in[14], DM, DM, DM, DM, W + W_OUT, nullptr, 0, 0);
        for (int kv = 0; kv < 2; ++kv) {
            conv_mat(lds, P.in[12] + (size_t)kv * 4096 * 128, 128, 4096, 128, 128, W + W_C1 + (size_t)kv * 128 * 4096, nullptr, 0, 0);
            conv_mat(lds, P.in[13] + (size_t)kv * 128 * 128, 128, 128, 128, 128, W + W_C2 + (size_t)kv * 128 * 128, nullptr, 0, 0);
        }
        {
            const int tid = otid(), wave = tid >> 6, lane = tid & 63;
            for (int o = blockIdx.x * 8 + wave; o < 256; o += gridDim.x * 8) {
                const int kv = o >> 7, e = o & 127;
                const float* pos = P.in[11] + (size_t)kv * 4096; const float* w1 = P.in[12] + (size_t)kv * 4096 * 128;
                float s = 0.f;
#pragma unroll 16
                for (int j = 0; j < 64; ++j) { const int i = lane + 64 * j; s += pos[i] * w1[(size_t)i * 128 + e]; }
                s = wsum(s);
                if (lane == 0) ((float*)(P.ws + WS_PBIAS))[o] = s;
            }
        }
        {
            const int gt = blockIdx.x * NTHREADS + otid();
            if (gt < S) ((float*)(P.ws + WS_RINV))[gt] = row_rinv((const float*)(P.ws + WS_SSQ), gt);
        }
        {
            bfraw* z = (bfraw*)(P.ws + WS_Z);
            const int gt = blockIdx.x * NTHREADS + otid();
            if (gt < 4 * 32 * 128) {
                const int which = gt / (32 * 128), rem = gt % (32 * 128);
                const size_t b = (which < 2 ? Z1_CK : Z1_CV) + (size_t)(which & 1) * CKV_HS + (size_t)S * 128 + rem;
                z[b] = 0;
            }
        }
    }
    const int l = layer;
    conv_mat(lds, P.in[16] + (size_t)l * DM * DFF, DFF, DM, DFF, DFF, W + W_GU, nf, 128, 0);
    conv_mat(lds, P.in[17] + (size_t)l * DM * DFF, DFF, DM, DFF, DFF, W + W_GU, nf, 128, 128);
    conv_mat(lds, P.in[18] + (size_t)l * DFF * DM, DM, DFF, DM, DM, W + W_D, nullptr, 0, 0);
    conv_mat(lds, P.in[19] + (size_t)l * DM * DM, DM, DM, DM, DM, W + W_PG, nullptr, 0, 0);
    conv_mat(lds, P.in[20] + (size_t)l * PLE * DM, DM, PLE, DM, DM, W + W_PP, nullptr, 0, 0);
}

__device__ __forceinline__ void phase_prep(CPR P) {
    const int tid = otid(), wave = tid >> 6, lane = tid & 63;
    const float* x = P.in[0]; bfraw* xb = (bfraw*)(P.ws + WS_XB); float* ssq = (float*)(P.ws + WS_SSQ);
    for (int row = blockIdx.x * 8 + wave; row < S; row += gridDim.x * 8) {
        float s = 0.f;
#pragma unroll
        for (int i = 0; i < 8; ++i) {
            const size_t o = (size_t)row * DM + i * 256 + lane * 4;
            f32x4 v = *(const f32x4*)(x + o);
            s += (v[0] * v[0] + v[1] * v[1]) + (v[2] * v[2] + v[3] * v[3]);
            st_bf4(xb + o, v);
        }
        s = wsum(s);
        if (lane < 32) ssq[(size_t)row * 32 + lane] = lane == 0 ? s : 0.f;
        if (lane == 0) ((float*)(P.ws + WS_RINV))[row] = rsqrtf(s * (1.0f / 2048.0f) + EPS);
    }
    if (blockIdx.x == 0 && tid < 8) ((unsigned*)(P.ws + WS_KMAX))[tid] = 0u;
    const float* p = P.in[1]; bfraw* pb = (bfraw*)(P.ws + WS_PB);
    const size_t n4 = (size_t)2 * S * PLE / 4;
    for (size_t i = (size_t)blockIdx.x * NTHREADS + tid; i < n4; i += (size_t)gridDim.x * NTHREADS) st_bf4(pb + i * 4, *(const f32x4*)(p + i * 4));
}

__device__ __forceinline__ void phase_final(CPR P) {
    const int tid = otid(), wave = tid >> 6, lane = tid & 63;
    float* x = P.out; const float* ssq = (const float*)(P.ws + WS_SSQ); const float* g = P.in[21];
    for (int row = blockIdx.x * 8 + wave; row < S; row += gridDim.x * 8) {
        const float ri = row_rinv(ssq, row);
#pragma unroll
        for (int i = 0; i < 8; ++i) {
            const size_t o = (size_t)row * DM + i * 256 + lane * 4;
            f32x4 v = *(const f32x4*)(x + o), gv = *(const f32x4*)(g + i * 256 + lane * 4);
            *(f32x4*)(x + o) = v * ri * gv;
        }
    }
}

__device__ __forceinline__ void fl_rows(CPR P, LAS unsigned char* lds) {
    const bfraw* xb = (const bfraw*)(P.ws + WS_XB); const bfraw* wfl = (const bfraw*)(P.ws + WS_W) + W_IN + (size_t)5120 * DM;
    const float* ssq = (const float*)(P.ws + WS_SSQ); float* fl = (float*)(P.ws + WS_FL);
    const int tid = otid(), wave = tid >> 6, lane = tid & 63;
    __syncthreads();
#pragma unroll
    for (int i = 0; i < 4; ++i) { const int c = tid + i * 512; *(LAS u32x4*)(lds + c * 16) = *(const u32x4*)(wfl + (size_t)c * 8); }
    __syncthreads();
    for (int row = blockIdx.x * 8 + wave; row < S; row += gridDim.x * 8) {
        float xv[32];
#pragma unroll
        for (int q = 0; q < 4; ++q) {
            const u32x4 v = *(const u32x4*)(xb + (size_t)row * DM + lane * 32 + q * 8);
#pragma unroll
            for (int e = 0; e < 4; ++e) { xv[q * 8 + 2 * e] = __uint_as_float(v[e] << 16); xv[q * 8 + 2 * e + 1] = __uint_as_float(v[e] & 0xffff0000u); }
        }
        float acc[8];
#pragma unroll
        for (int j = 0; j < 8; ++j) {
            float a = 0.f;
#pragma unroll
            for (int q = 0; q < 4; ++q) {
                const u32x4 w = *(const LAS u32x4*)(lds + j * 4096 + lane * 64 + q * 16);
#pragma unroll
                for (int e = 0; e < 4; ++e) { a += xv[q * 8 + 2 * e] * __uint_as_float(w[e] << 16); a += xv[q * 8 + 2 * e + 1] * __uint_as_float(w[e] & 0xffff0000u); }
            }
            acc[j] = wsum(a);
            __builtin_amdgcn_sched_barrier(0);
        }
        const float ri = ((const float*)(P.ws + WS_RINV))[row];
        if (lane < 8) {
            float v = acc[0];
#pragma unroll
            for (int j = 1; j < 8; ++j) v = (lane == j) ? acc[j] : v;
            fl[(size_t)lane * S + row] = v * ri;
        }
    }
    __syncthreads();
}

__device__ __forceinline__ void mm128(const LAS unsigned char* A, int astr, const LAS unsigned char* B, int bstr, int Kdim, f32x16 (&acc)[2]) {
    const int tid = otid(), w = tid >> 6, lane = tid & 63, ql = lane & 31, g = lane >> 5;
    const LAS unsigned char* ap = A + ((w >> 1) * 32 + ql) * astr + g * 16;
    const LAS unsigned char* bp0 = B + ((w & 1) * 64 + ql) * bstr + g * 16;
    const LAS unsigned char* bp1 = bp0 + 32 * bstr;
    (void)Kdim;
    bf16x8 a = *(const LAS bf16x8*)(ap), b0 = *(const LAS bf16x8*)(bp0), b1 = *(const LAS bf16x8*)(bp1);
#pragma unroll
    for (int kk = 0; kk < 8; ++kk) {
        bf16x8 na = a, nb0 = b0, nb1 = b1;
        if (kk + 1 < 8) { na = *(const LAS bf16x8*)(ap + (kk + 1) * 32); nb0 = *(const LAS bf16x8*)(bp0 + (kk + 1) * 32); nb1 = *(const LAS bf16x8*)(bp1 + (kk + 1) * 32); }
        __builtin_amdgcn_sched_barrier(0);
        acc[0] = __builtin_amdgcn_mfma_f32_32x32x16_bf16(a, b0, acc[0], 0, 0, 0);
        acc[1] = __builtin_amdgcn_mfma_f32_32x32x16_bf16(a, b1, acc[1], 0, 0, 0);
        __builtin_amdgcn_sched_barrier(0);
        a = na; b0 = nb0; b1 = nb1;
    }
}
constexpr int T128 = 272;
__device__ __forceinline__ void stage128(LAS unsigned char* dst, const bfraw* src, size_t ld) {
    const int tid = otid();
#pragma unroll
    for (int i = 0; i < 4; ++i) { const int c = tid + i * 512, row = c >> 4, col = c & 15; *(LAS u32x4*)(dst + row * T128 + col * 16) = *(const u32x4*)(src + (size_t)row * ld + col * 8); }
}
__device__ __forceinline__ float lgam2_of(int h) { return log1pf(-exp2f(-5.0f - (float)h)) * LOG2E; }

__device__ __forceinline__ void ret_upd_item(CPR P, LAS unsigned char* lds, int h, int n) {
    const bfraw* z = (const bfraw*)(P.ws + WS_Z); float* st = (float*)(P.ws + WS_XB);
    const int tid = otid();
    const float lg = lgam2_of(h);
    __syncthreads();
    stage128(lds, z + Z0_VT + (size_t)(h * 128) * S + n * 128, S);
    LAS unsigned char* B = lds + 128 * T128;
    const bfraw* kp = z + Z0_RQK + ((size_t)(8 + h) * S + n * 128) * 128;
#pragma unroll
    for (int i = 0; i < 4; ++i) {
        const int c = tid + i * 512, s = c >> 4, col = c & 15;
        const u32x4 v = *(const u32x4*)(kp + (size_t)s * 128 + col * 8);
        const float kw = fexp2(lg * (float)(127 - s)) * 0.08838834764831845f;
#pragma unroll
        for (int j = 0; j < 4; ++j) {
            const float lo = __uint_as_float(v[j] << 16) * kw, hi = __uint_as_float(v[j] & 0xffff0000u) * kw;
            *(LAS bfraw*)(B + (col * 8 + 2 * j) * T128 + s * 2) = f2bf(lo);
            *(LAS bfraw*)(B + (col * 8 + 2 * j + 1) * T128 + s * 2) = f2bf(hi);
        }
    }
    __syncthreads();
    f32x16 acc[2]; acc[0] = (f32x16)(0.f); acc[1] = (f32x16)(0.f);
    mm128(lds, T128, B, T128, 128, acc);
    const int w = tid >> 6, lane = tid & 63, ql = lane & 31, g = lane >> 5;
    float* o = st + ((size_t)(h * 128 + n) * 128) * 128;
#pragma unroll
    for (int nb = 0; nb < 2; ++nb)
#pragma unroll
        for (int r = 0; r < 16; ++r) {
            const int row = (w >> 1) * 32 + (r & 3) + 8 * (r >> 2) + 4 * g, col = (w & 1) * 64 + nb * 32 + ql;
            o[(size_t)row * 128 + col] = acc[nb][r];
        }
}
__device__ __forceinline__ void phase_ret_scan(CPR P) {
    float* st = (float*)(P.ws + WS_XB);
    for (int e = blockIdx.x * NTHREADS + otid(); e < 8 * 16384; e += gridDim.x * NTHREADS) {
        const int h = e >> 14, idx = e & 16383;
        const float decay = fexp2(lgam2_of(h) * 128.0f);
        float* p = st + (size_t)h * 128 * 16384 + idx;
        float state = 0.f;
        for (int n = 0; n < 128; n += 8) {
            float u[8];
#pragma unroll
            for (int i = 0; i < 8; ++i) u[i] = p[(size_t)(n + i) * 16384];
#pragma unroll
            for (int i = 0; i < 8; ++i) { p[(size_t)(n + i) * 16384] = state; state = state * decay + u[i]; }
        }
    }
}
__device__ __forceinline__ void ret_out_item(CPR P, LAS unsigned char* lds, int h, int n) {
    const bfraw* z = (const bfraw*)(P.ws + WS_Z); const float* st = (const float*)(P.ws + WS_XB); bfraw* mix = (bfraw*)(P.ws + WS_M);
    const int tid = otid(), w = tid >> 6, lane = tid & 63, ql = lane & 31, g = lane >> 5;
    const float lg = lgam2_of(h);
    LAS unsigned char* Qs = lds; LAS unsigned char* Ks = lds + 128 * T128; LAS unsigned char* Vs = lds + 2 * 128 * T128; LAS unsigned char* Xs = lds + 3 * 128 * T128;
    __syncthreads();
    stage128(Qs, z + Z0_RQK + ((size_t)h * S + n * 128) * 128, 128);
    stage128(Ks, z + Z0_RQK + ((size_t)(8 + h) * S + n * 128) * 128, 128);
    stage128(Vs, z + Z0_VT + (size_t)(h * 128) * S + n * 128, S);
    {
        const float* sp = st + ((size_t)(h * 128 + n) * 128) * 128;
#pragma unroll
        for (int i = 0; i < 8; ++i) {
            const int c = tid + i * 512, row = c >> 5, col = c & 31;
            const f32x4 v = *(const f32x4*)(sp + (size_t)row * 128 + col * 4);
            u32x2 o; o[0] = pack2(v[0], v[1]); o[1] = pack2(v[2], v[3]);
            *(LAS u32x2*)(Xs + row * T128 + col * 8) = o;
        }
    }
    __syncthreads();
    f32x16 accY[2], accA[2];
    accY[0] = (f32x16)(0.f); accY[1] = (f32x16)(0.f); accA[0] = (f32x16)(0.f); accA[1] = (f32x16)(0.f);
    mm128(Qs, T128, Xs, T128, 128, accY);
    mm128(Qs, T128, Ks, T128, 128, accA);
#pragma unroll
    for (int nb = 0; nb < 2; ++nb)
#pragma unroll
        for (int r = 0; r < 16; ++r) {
            const int c = (w >> 1) * 32 + (r & 3) + 8 * (r >> 2) + 4 * g, col = (w & 1) * 64 + nb * 32 + ql;
            accY[nb][r] *= fexp2(lg * (float)(c + 1));
            const int rel = c - col;
            accA[nb][r] = rel >= 0 ? accA[nb][r] * 0.08838834764831845f * fexp2(lg * (float)rel) : 0.f;
        }
    __syncthreads();
#pragma unroll
    for (int nb = 0; nb < 2; ++nb)
#pragma unroll
        for (int r = 0; r < 16; ++r) {
            const int c = (w >> 1) * 32 + (r & 3) + 8 * (r >> 2) + 4 * g, col = (w & 1) * 64 + nb * 32 + ql;
            *(LAS bfraw*)(Xs + c * T128 + col * 2) = f2bf(accA[nb][r]);
        }
    __syncthreads();
    mm128(Xs, T128, Vs, T128, 128, accY);
    __syncthreads();
    LAS float* Ys = (LAS float*)lds;
#pragma unroll
    for (int nb = 0; nb < 2; ++nb)
#pragma unroll
        for (int r = 0; r < 16; ++r) {
            const int c = (w >> 1) * 32 + (r & 3) + 8 * (r >> 2) + 4 * g, col = (w & 1) * 64 + nb * 32 + ql;
            Ys[c * 132 + col] = accY[nb][r];
        }
    __syncthreads();
    const float* gn = P.in[5];
    const bfraw* rg = z + Z0_RG;
    bfraw gq0[16], gq1[16];
#pragma unroll
    for (int i = 0; i < 16; ++i) { const int t = n * 128 + w * 16 + i; gq0[i] = rg[(size_t)t * 1024 + h * 128 + lane]; gq1[i] = rg[(size_t)t * 1024 + h * 128 + 64 + lane]; }
    const float gn0 = gn[h * 128 + lane], gn1 = gn[h * 128 + 64 + lane];
#pragma unroll
    for (int i = 0; i < 16; ++i) {
        const int c = w * 16 + i, t = n * 128 + c;
        const float v0 = Ys[c * 132 + lane], v1 = Ys[c * 132 + 64 + lane];
        const float mean = wsum(v0 + v1) * (1.0f / 128.0f);
        const float d0 = v0 - mean, d1 = v1 - mean;
        const float var = wsum(d0 * d0 + d1 * d1) * (1.0f / 128.0f);
        const float rstd = rsqrtf(var + EPS);
        const float g0 = bf2f(gq0[i]), g1 = bf2f(gq1[i]);
        mix[(size_t)t * DM + h * 128 + lane] = f2bf(d0 * rstd * gn0 * siluf_(g0));
        mix[(size_t)t * DM + h * 128 + 64 + lane] = f2bf(d1 * rstd * gn1 * siluf_(g1));
    }
}
__device__ __forceinline__ void fox_cumsum_item(CPR P, LAS unsigned char* lds, int h) {
    const float* fl = (const float*)(P.ws + WS_FL) + (size_t)h * S; float* c2 = (float*)(P.ws + WS_C2) + (size_t)h * S;
    const float fb = P.in[6][h];
    const int tid = otid();
    LAS double* sc = (LAS double*)lds;
    __syncthreads();
    float ls[32]; double tot = 0.0;
#pragma unroll
    for (int i = 0; i < 32; ++i) { const float x = fl[tid * 32 + i] + fb; ls[i] = fminf(x, 0.f) - log1pf(__expf(-fabsf(x))); tot += (double)ls[i]; }
    sc[tid] = tot;
    __syncthreads();
    for (int off = 1; off < 512; off <<= 1) {
        double v = tid >= off ? sc[tid - off] : 0.0;
        __syncthreads();
        sc[tid] += v;
        __syncthreads();
    }
    double run = sc[tid] - tot;
#pragma unroll
    for (int i = 0; i < 32; ++i) { run += (double)ls[i]; c2[tid * 32 + i] = (float)(run * 1.4426950408889634); }
    __syncthreads();
}

__device__ __forceinline__ void fox_kmax_item(CPR P, LAS unsigned char* lds, int h, int c) {
    const bfraw* k = (const bfraw*)(P.ws + WS_Z) + Z0_FQK + ((size_t)(8 + h) * S + (size_t)c * 2048) * 128;
    const int tid = otid();
    float mx = 0.f;
    for (int i = 0; i < 4; ++i) {
        const bfraw* row = k + (size_t)(tid * 4 + i) * 128;
        float s = 0.f;
#pragma unroll
        for (int q = 0; q < 16; ++q) {
            const u32x4 v = *(const u32x4*)(row + q * 8);
#pragma unroll
            for (int e = 0; e < 4; ++e) { const float lo = __uint_as_float(v[e] << 16), hi = __uint_as_float(v[e] & 0xffff0000u); s += lo * lo + hi * hi; }
        }
        mx = fmaxf(mx, s);
    }
#pragma unroll
    for (int o = 32; o >= 1; o >>= 1) mx = fmaxf(mx, __shfl_xor(mx, o));
    if ((tid & 63) == 0) atomicMax((unsigned*)(P.ws + WS_KMAX) + h, __float_as_uint(mx));
}

constexpr int F_KB0 = 0, F_KBS = 17408, F_VB0 = 34816, F_VBS = 18432, F_CT = 71680, F_TB = 72192, F_UN = 74304, F_IMP = 74752;
enum { M_FOX = 0, M_DIFF = 1, M_WIN = 2, M_SLC = 3, M_CMP = 4 };
__device__ __forceinline__ f32x16 mfma32(bf16x8 a, bf16x8 b, f32x16 c) { return __builtin_amdgcn_mfma_f32_32x32x16_bf16(a, b, c, 0, 0, 0); }
__device__ __forceinline__ int t5_bucket(int d) {
    if (d < 16) return d;
    int b = 16 + (int)(logf((float)d / 16.0f) / 2.0794415416798357f * 16.0f);
    return b < 31 ? b : 31;
}
__device__ __forceinline__ void build_t5(LAS float* tb, const float* table, int col) {
    const int d = otid();
    if (d <= 128) tb[d] = (table[t5_bucket(d) * 16 + col] - table[31 * 16 + col]) * LOG2E;
}
__device__ __forceinline__ int next_sel(const LAS unsigned* un, int j, int hi) {
    int jj = j + 1;
    if (jj > hi) return hi + 1;
    int w = jj >> 5; unsigned mask = un[w] & (~0u << (jj & 31));
    for (;;) {
        if (mask) { const int r = w * 32 + __ffs(mask) - 1; return r <= hi ? r : hi + 1; }
        ++w; if (w > (hi >> 5)) return hi + 1;
        mask = un[w];
    }
}

template <int DK> struct StageRegs { u32x4 k[DK == 128 ? 2 : 1]; u32x4 v[2]; float c; };

template <int MODE, int DK, bool PASS2>
__device__ __forceinline__ void flash_loop(LAS unsigned char* lds, const bfraw* Kg, int k_ld, const bfraw* Vtg, int vt_ld, const float* cg2,
                                           int tile_lo, int tile_hi, const bf16x8 (&qf)[DK / 16], int t_lane, int t_wmin, int t_wmax, float sl2,
                                           const LAS float* tb, float qnb,
                                           f32x16 (&O)[4], float& m_run, float& l_run, LAS float* impw) {
    constexpr int KSTR = DK * 2 + 16;
    const int tid = otid(), lane = tid & 63, ql = lane & 31, g = lane >> 5;
    const int prow = (ql & 19) | ((ql & 4) << 1) | ((ql & 8) >> 1);
    const LAS unsigned* un = (const LAS unsigned*)(lds + F_UN);
    const float rsl2 = 1.0f / sl2;
    StageRegs<DK> sr;
    auto load_tile = [&](int j) {
        const int kv0 = j * 64;
        if (DK == 128) {
#pragma unroll
            for (int i = 0; i < 2; ++i) { const int c = tid + i * 512, row = c >> 4, col = c & 15; sr.k[i] = *(const u32x4*)((const char*)Kg + (unsigned)(((kv0 + row) * k_ld + col * 8) * 2)); }
        } else {
            const int row = tid >> 3, col = tid & 7; sr.k[0] = *(const u32x4*)((const char*)Kg + (unsigned)(((kv0 + row) * k_ld + col * 8) * 2));
        }
        if (!PASS2) {
#pragma unroll
            for (int i = 0; i < 2; ++i) { const int c = tid + i * 512, row = c >> 3, col = c & 7; sr.v[i] = *(const u32x4*)((const char*)Vtg + (unsigned)((row * vt_ld + kv0 + col * 8) * 2)); }
        }
        if (MODE == M_FOX) { if (tid < 64) sr.c = cg2[kv0 + tid]; }
    };
    auto write_tile = [&](int buf) {
        if (DK == 128) {
#pragma unroll
            for (int i = 0; i < 2; ++i) { const int c = tid + i * 512, row = c >> 4, col = c & 15; *(LAS u32x4*)(lds + F_KB0 + buf * F_KBS + row * KSTR + col * 16) = sr.k[i]; }
        } else {
            const int row = tid >> 3, col = tid & 7; *(LAS u32x4*)(lds + F_KB0 + buf * F_KBS + row * KSTR + col * 16) = sr.k[0];
        }
        if (!PASS2) {
#pragma unroll
            for (int i = 0; i < 2; ++i) { const int c = tid + i * 512, row = c >> 3, col = c & 7; *(LAS u32x4*)(lds + F_VB0 + buf * F_VBS + row * 144 + col * 16) = sr.v[i]; }
        }
        if (MODE == M_FOX) { if (tid < 64) *(LAS float*)(lds + F_CT + buf * 256 + tid * 4) = -sr.c * rsl2; }
    };
    int j = (MODE == M_SLC) ? next_sel(un, tile_lo - 1, tile_hi) : (MODE == M_FOX ? tile_hi : tile_lo);
    if (MODE != M_FOX && j > tile_hi) return;
    float carry = 0.f;
    load_tile(j); write_tile(0);
    __syncthreads();
    int buf = 0;
    for (;;) {
        const int jn = (MODE == M_SLC) ? next_sel(un, j, tile_hi) : (MODE == M_FOX ? j - 1 : j + 1);
        const bool has = (MODE == M_FOX) ? (jn >= tile_lo) : (jn <= tile_hi);
        if (has) load_tile(jn);
        bool dead = false;
        {
            const int kv0 = j * 64;
            const int pos_min = (MODE == M_CMP) ? 16 * kv0 + 31 : kv0;
            const int pos_max = (MODE == M_CMP) ? 16 * (kv0 + 63) + 31 : kv0 + 63;
            bool active = pos_min <= t_wmax;
            if (MODE == M_WIN) active = active && (t_wmin - pos_max < 512);
            bool selbit = true;
            if (MODE == M_SLC) {
                selbit = ((((const LAS unsigned*)impw)[j >> 5] >> (j & 31)) & 1u) != 0u;
                active = active && (__builtin_amdgcn_ballot_w64(selbit) != 0ull);
            }
            if (active) {
                f32x16 s0, s1;
                if (MODE == M_FOX) {
                    const LAS float* ct = (const LAS float*)(lds + F_CT + buf * 256) + 8 * g;
#pragma unroll
                    for (int q4 = 0; q4 < 4; ++q4) {
                        const f32x4 a = *(const LAS f32x4*)(ct + (q4 >> 1) * 16 + (q4 & 1) * 4), b = *(const LAS f32x4*)(ct + 32 + (q4 >> 1) * 16 + (q4 & 1) * 4);
#pragma unroll
                        for (int e = 0; e < 4; ++e) { s0[q4 * 4 + e] = a[e]; s1[q4 * 4 + e] = b[e]; }
                    }
                } else { s0 = (f32x16)(0.f); s1 = (f32x16)(0.f); }
                const LAS unsigned char* kb = lds + F_KB0 + buf * F_KBS + g * 16 + prow * KSTR;
                __builtin_amdgcn_s_setprio(1);
#pragma unroll
                for (int kk = 0; kk < DK / 16; ++kk) {
                    const bf16x8 a0 = *(const LAS bf16x8*)(kb + kk * 32);
                    const bf16x8 a1 = *(const LAS bf16x8*)(kb + 32 * KSTR + kk * 32);
                    s0 = mfma32(a0, qf[kk], s0); s1 = mfma32(a1, qf[kk], s1);
                }
                __builtin_amdgcn_s_setprio(0);
                const bool need_causal = pos_max > t_wmin;
                const bool need_bias = (MODE != M_FOX) && ((t_wmin - pos_max) < 128);
                const bool need_win = (MODE == M_WIN) && (t_wmax - pos_min >= 512);
                if (!PASS2 && !(need_causal || need_bias || need_win)) {
                    float mx = fmaxf(s0[0], s1[0]);
#pragma unroll
                    for (int r = 1; r < 16; ++r) mx = fmax3(mx, s0[r], s1[r]);
                    if (MODE == M_SLC) mx = selbit ? mx : NEG;
                    mx = xhalf_max(mx);
                    const float mxs = mx * sl2;
                    const float mn = (mxs > m_run + 8.0f) ? mxs : m_run;
                    const float alpha = fexp2(m_run - mn);
                    m_run = mn;
                    float nm = -mn;
                    if (MODE == M_SLC) nm = selbit ? nm : -__builtin_inff();
                    float ps0 = 0.f, ps1 = 0.f;
#pragma unroll
                    for (int r = 0; r < 16; ++r) {
                        s0[r] = fexp2(__builtin_fmaf(s0[r], sl2, nm)); s1[r] = fexp2(__builtin_fmaf(s1[r], sl2, nm));
                        ps0 += s0[r]; ps1 += s1[r];
                    }
                    l_run = l_run * alpha + (ps0 + ps1);
                    if (__builtin_amdgcn_ballot_w64(alpha != 1.0f) != 0ull) {
#pragma unroll
                        for (int db = 0; db < 4; ++db)
#pragma unroll
                            for (int r = 0; r < 16; ++r) O[db][r] *= alpha;
                    }
                } else {
#pragma unroll
                    for (int r = 0; r < 16; ++r) { s0[r] *= sl2; s1[r] *= sl2; }
                    if (need_bias || need_causal || need_win) {
#pragma unroll
                        for (int i = 0; i < 32; ++i) {
                            const int s = kv0 + (i >> 3) * 16 + 8 * g + (i & 7);
                            const int dist = t_lane - ((MODE == M_CMP) ? 16 * s + 31 : s);
                            float v = (i < 16) ? s0[i & 15] : s1[i & 15];
                            if (need_bias) { const int di = dist < 0 ? 0 : (dist > 128 ? 128 : dist); v += tb[di]; }
                            bool msk = dist < 0;
                            if (MODE == M_WIN) msk = msk || dist >= 512;
                            if (msk) v = NEG;
                            if (i < 16) s0[i & 15] = v; else s1[i & 15] = v;
                            if ((i & 7) == 7) __builtin_amdgcn_sched_barrier(0);
                        }
                    }
                    if (MODE == M_SLC) {
                        if (!selbit) {
#pragma unroll
                            for (int r = 0; r < 16; ++r) { s0[r] = NEG; s1[r] = NEG; }
                        }
                    }
                    if (!PASS2) {
                        float mx = fmaxf(s0[0], s1[0]);
#pragma unroll
                        for (int r = 1; r < 16; ++r) mx = fmax3(mx, s0[r], s1[r]);
                        mx = xhalf_max(mx);
                        const float mn = (mx > m_run + 8.0f) ? mx : m_run;
                        const float alpha = fexp2(m_run - mn);
                        m_run = mn;
                        float ps0 = 0.f, ps1 = 0.f;
#pragma unroll
                        for (int r = 0; r < 16; ++r) { s0[r] = fexp2(s0[r] - mn); s1[r] = fexp2(s1[r] - mn); ps0 += s0[r]; ps1 += s1[r]; }
                        l_run = l_run * alpha + (ps0 + ps1);
                        if (__builtin_amdgcn_ballot_w64(alpha != 1.0f) != 0ull) {
#pragma unroll
                            for (int db = 0; db < 4; ++db)
#pragma unroll
                                for (int r = 0; r < 16; ++r) O[db][r] *= alpha;
                        }
                    }
                }
                if (!PASS2) {
                    bf16x8 pf[4];
#pragma unroll
                    for (int k2 = 0; k2 < 4; ++k2) {
                        u32x4 pk;
#pragma unroll
                        for (int e = 0; e < 4; ++e) pk[e] = (k2 < 2) ? pack2(s0[(k2 & 1) * 8 + 2 * e], s0[(k2 & 1) * 8 + 2 * e + 1]) : pack2(s1[(k2 & 1) * 8 + 2 * e], s1[(k2 & 1) * 8 + 2 * e + 1]);
                        pf[k2] = __builtin_bit_cast(bf16x8, pk);
                    }
                    const LAS unsigned char* vb = lds + F_VB0 + buf * F_VBS + ql * 144 + g * 16;
                    __builtin_amdgcn_s_setprio(1);
#pragma unroll
                    for (int db = 0; db < 4; ++db)
#pragma unroll
                        for (int k2 = 0; k2 < 4; ++k2) {
                            const bf16x8 vf = *(const LAS bf16x8*)(vb + db * 32 * 144 + k2 * 32);
                            O[db] = mfma32(vf, pf[k2], O[db]);
                            if (k2 == 3 && (db & 1)) __builtin_amdgcn_sched_barrier(0);
                        }
                    __builtin_amdgcn_s_setprio(0);
                    if (MODE == M_FOX) {
                        if (has) { const float cn = cg2[jn * 64 + 63]; dead = __builtin_amdgcn_ballot_w64(!((qnb - cn) - m_run < -160.0f)) == 0ull; }
                    }
                } else {
                    float I0[4], I1[4], e7[4];
#pragma unroll
                    for (int c = 0; c < 4; ++c) {
                        float p[8];
#pragma unroll
                        for (int e = 0; e < 8; ++e) p[e] = fexp2(((c < 2) ? s0[(c & 1) * 8 + e] : s1[(c & 1) * 8 + e]) - m_run) * l_run;
                        I0[c] = (p[0] + p[1]) + (p[2] + p[3]);
                        I1[c] = (p[4] + p[5]) + (p[6] + p[7]) + p[3];
                        e7[c] = p[7];
                    }
                    float rc[4];
#pragma unroll
                    for (int c = 0; c < 4; ++c) rc[c] = __shfl_xor(e7[c], 32);
                    if (g == 1) {
#pragma unroll
                        for (int c = 0; c < 4; ++c) I0[c] += rc[c];
                    } else {
                        I0[0] += carry; I0[1] += rc[0]; I0[2] += rc[1]; I0[3] += rc[2];
                        carry = rc[3];
                    }
#pragma unroll
                    for (int c = 0; c < 4; ++c) {
                        I0[c] += dppf<0xB1>(I0[c]); I0[c] += dppf<0x4E>(I0[c]);
                        I1[c] += dppf<0xB1>(I1[c]); I1[c] += dppf<0x4E>(I1[c]);
                    }
                    if ((ql & 3) == 0) {
#pragma unroll
                        for (int c = 0; c < 4; ++c) {
                            impw[(ql >> 2) * 256 + 16 * j + 2 * g + 4 * c] = I0[c];
                            impw[(ql >> 2) * 256 + 16 * j + 2 * g + 4 * c + 1] = I1[c];
                        }
                    }
                }
            }
        }
        if (has) write_tile(buf ^ 1);
        if (MODE == M_FOX) { if (__syncthreads_and(dead ? 1 : 0)) break; }
        else __syncthreads();
        if (!has) break;
        j = jn; buf ^= 1;
    }
}

__device__ __forceinline__ void load_q128(bf16x8 (&qf)[8], const bfraw* qrow, int g) {
#pragma unroll
    for (int kk = 0; kk < 8; ++kk) qf[kk] = *(const bf16x8*)(qrow + kk * 16 + g * 8);
}

__device__ __forceinline__ void fox_item(CPR P, LAS unsigned char* lds, int h, int qb) {
    const bfraw* z = (const bfraw*)(P.ws + WS_Z); bfraw* mix = (bfraw*)(P.ws + WS_M);
    const float* c2 = (const float*)(P.ws + WS_C2) + (size_t)h * S;
    const int tid = otid(), wave = tid >> 6, lane = tid & 63, ql = lane & 31, g = lane >> 5;
    const int q0 = qb * 256, t = q0 + wave * 32 + ql;
    bf16x8 qf[8];
    load_q128(qf, z + Z0_FQK + ((size_t)h * S + t) * 128, g);
    float qn2 = 0.f;
#pragma unroll
    for (int kk = 0; kk < 8; ++kk)
#pragma unroll
        for (int e = 0; e < 8; ++e) { const float v = bf2f((unsigned short)qf[kk][e]); qn2 += v * v; }
    qn2 += __shfl_xor(qn2, 32);
    const float kmax2 = __uint_as_float(((const unsigned*)(P.ws + WS_KMAX))[h]);
    const float qnb = sqrtf(qn2 * kmax2) * (0.08838834764831845f * LOG2E * 1.01f) + 1.0f;
    f32x16 O[4];
#pragma unroll
    for (int i = 0; i < 4; ++i) O[i] = (f32x16)(0.f);
    float m = NEG, l = 0.f;
    __syncthreads();
    flash_loop<M_FOX, 128, false>(lds, z + Z0_FQK + (size_t)(8 + h) * S * 128, 128, z + Z0_VT + (size_t)(1024 + h * 128) * S, S, c2,
                                  0, (q0 + 255) >> 6, qf, t, q0 + wave * 32, q0 + wave * 32 + 31, 0.08838834764831845f * LOG2E,
                                  nullptr, qnb, O, m, l, nullptr);
    l += __shfl_xor(l, 32);
    const float inv = 1.0f / l;
    bfraw* orow = mix + (size_t)t * DM + 1024 + h * 128 + 4 * g;
#pragma unroll
    for (int db = 0; db < 4; ++db)
#pragma unroll
        for (int r4 = 0; r4 < 4; ++r4) {
            f32x4 v; v[0] = O[db][r4 * 4] * inv; v[1] = O[db][r4 * 4 + 1] * inv; v[2] = O[db][r4 * 4 + 2] * inv; v[3] = O[db][r4 * 4 + 3] * inv;
            st_bf4(orow + db * 32 + r4 * 8, v);
        }
}

__device__ __forceinline__ void diff_item(CPR P, LAS unsigned char* lds, int h, int qb) {
    const bfraw* z = (const bfraw*)(P.ws + WS_Z); bfraw* mix = (bfraw*)(P.ws + WS_M);
    const int tid = otid(), wave = tid >> 6, lane = tid & 63, ql = lane & 31, g = lane >> 5;
    const int q0 = qb * 256, t = q0 + wave * 32 + ql;
    const float* lam = P.in[9];
    const float sa = wsum(lam[lane] * lam[64 + lane]), sb = wsum(lam[128 + lane] * lam[192 + lane]);
    const float lmbda = __expf(sa) - __expf(sb) + LINIT;
    LAS float* tb = (LAS float*)(lds + F_TB);
    __syncthreads();
    build_t5(tb, P.in[15], h);
    __syncthreads();
    LAS unsigned* hold = (LAS unsigned*)(lds + F_IMP) + otid();
    f32x16 O[4];
    for (int mp = 0; mp < 2; ++mp) {
        bf16x8 qf[4];
        const bfraw* qrow = z + Z1_DQK + ((size_t)(h * 2 + mp) * S + t) * 64;
#pragma unroll
        for (int kk = 0; kk < 4; ++kk) qf[kk] = *(const bf16x8*)(qrow + kk * 16 + g * 8);
#pragma unroll
        for (int i = 0; i < 4; ++i) O[i] = (f32x16)(0.f);
        float m = NEG, l = 0.f;
        flash_loop<M_DIFF, 64, false>(lds, z + Z1_DQK + (size_t)(16 + h * 2 + mp) * S * 64, 64, z + Z1_VT + (size_t)(h * 128) * S, S, nullptr,
                                      0, (q0 + 255) >> 6, qf, t, q0 + wave * 32, q0 + wave * 32 + 31, 0.125f * LOG2E,
                                      tb, 0.f, O, m, l, nullptr);
        l += __shfl_xor(l, 32);
        const float inv = 1.0f / l;
        if (mp == 0) {
#pragma unroll
            for (int db = 0; db < 4; ++db)
#pragma unroll
                for (int r = 0; r < 8; ++r) hold[(db * 8 + r) * 512] = pack2(O[db][2 * r] * inv, O[db][2 * r + 1] * inv);
        } else {
            float ss = 0.f;
#pragma unroll
            for (int db = 0; db < 4; ++db)
#pragma unroll
                for (int r = 0; r < 8; ++r) {
                    const unsigned hv = hold[(db * 8 + r) * 512];
                    const float a = __uint_as_float(hv << 16) - lmbda * (O[db][2 * r] * inv);
                    const float b = __uint_as_float(hv & 0xffff0000u) - lmbda * (O[db][2 * r + 1] * inv);
                    O[db][2 * r] = a; O[db][2 * r + 1] = b;
                    ss += a * a + b * b;
                }
            ss += __shfl_xor(ss, 32);
            const float rn = rsqrtf(ss * (1.0f / 128.0f) + EPS) * (1.0f - LINIT);
            const float* sg = P.in[10];
            bfraw* orow = mix + (size_t)t * DM + h * 128 + 4 * g;
#pragma unroll
            for (int db = 0; db < 4; ++db)
#pragma unroll
                for (int r4 = 0; r4 < 4; ++r4) {
                    const f32x4 gv = *(const f32x4*)(sg + db * 32 + r4 * 8 + 4 * g);
                    f32x4 v;
#pragma unroll
                    for (int e = 0; e < 4; ++e) v[e] = O[db][r4 * 4 + e] * rn * gv[e];
                    st_bf4(orow + db * 32 + r4 * 8, v);
                }
        }
    }
}

template <int MODE>
__device__ __forceinline__ void nsa_item(CPR P, LAS unsigned char* lds, int h, int qb) {
    const bfraw* z = (const bfraw*)(P.ws + WS_Z); bfraw* mix = (bfraw*)(P.ws + WS_M);
    bfraw* ocmp = (bfraw*)(P.ws + WS_XB); bfraw* owin = ocmp + (size_t)S * 1024;
    const float* gates = (const float*)(P.ws + WS_GATES);
    const unsigned* selg = (const unsigned*)(P.ws + WS_SEL);
    const int tid = otid(), wave = tid >> 6, lane = tid & 63, ql = lane & 31, g = lane >> 5;
    const int q0 = qb * 256, t = q0 + wave * 32 + ql, kvh = h >> 2;
    LAS float* tb = (LAS float*)(lds + F_TB);
    LAS unsigned* un = (LAS unsigned*)(lds + F_UN);
    LAS unsigned* selL = (LAS unsigned*)(lds + F_IMP) + (wave * 32 + ql) * 9;
    __syncthreads();
    build_t5(tb, P.in[15], 8 + h);
    if (MODE == M_SLC) { if (tid < 8) un[tid] = 0u; }
    __syncthreads();
    if (MODE == M_SLC) {
        const u32x4 a = *(const u32x4*)(selg + ((size_t)t * 2 + kvh) * 8), b = *(const u32x4*)(selg + ((size_t)t * 2 + kvh) * 8 + 4);
        if (g == 0) {
#pragma unroll
            for (int q = 0; q < 4; ++q) { atomicOr((unsigned*)(un + q), a[q]); atomicOr((unsigned*)(un + 4 + q), b[q]); selL[q] = a[q]; selL[4 + q] = b[q]; }
        }
        __syncthreads();
    }
    bf16x8 qf[8];
    load_q128(qf, z + Z1_NQ + ((size_t)h * S + t) * 128, g);
    f32x16 O[4];
#pragma unroll
    for (int i = 0; i < 4; ++i) O[i] = (f32x16)(0.f);
    float m = NEG, l = 0.f;
    const int tile_hi = (q0 + 255) >> 6;
    if (MODE == M_WIN) {
        const int lo = q0 >= 511 ? (q0 - 511) >> 6 : 0;
        flash_loop<M_WIN, 128, false>(lds, z + Z1_WK + (size_t)kvh * S * 128, 128, z + Z1_VT + (size_t)(1280 + kvh * 128) * S, S, nullptr,
                                      lo, tile_hi, qf, t, q0 + wave * 32, q0 + wave * 32 + 31, 0.08838834764831845f * LOG2E, tb, 0.f, O, m, l, nullptr);
    } else {
        flash_loop<M_SLC, 128, false>(lds, z + Z1_SK + (size_t)kvh * S * 128, 128, z + Z1_VT + (size_t)(1024 + kvh * 128) * S, S, nullptr,
                                      0, tile_hi, qf, t, q0 + wave * 32, q0 + wave * 32 + 31, 0.08838834764831845f * LOG2E, tb, 0.f, O, m, l, (LAS float*)selL);
    }
    l += __shfl_xor(l, 32);
    const float gate = gates[(size_t)t * 24 + (MODE == M_WIN ? 16 : 8) + h];
    const float sc = gate / l;
    const size_t ob = (size_t)t * 1024 + h * 128 + 4 * g;
    u32x2 cq[16], wq[16];
    if (MODE == M_SLC) {
#pragma unroll
        for (int i = 0; i < 16; ++i) { const size_t o = ob + (i >> 2) * 32 + (i & 3) * 8; cq[i] = *(const u32x2*)(ocmp + o); wq[i] = *(const u32x2*)(owin + o); }
    }
#pragma unroll
    for (int db = 0; db < 4; ++db)
#pragma unroll
        for (int r4 = 0; r4 < 4; ++r4) {
            f32x4 v; v[0] = O[db][r4 * 4] * sc; v[1] = O[db][r4 * 4 + 1] * sc; v[2] = O[db][r4 * 4 + 2] * sc; v[3] = O[db][r4 * 4 + 3] * sc;
            const size_t o = ob + db * 32 + r4 * 8;
            if (MODE == M_WIN) st_bf4(owin + o, v);
            else {
                const u32x2 c = cq[db * 4 + r4], w = wq[db * 4 + r4];
                v[0] += __uint_as_float(c[0] << 16) + __uint_as_float(w[0] << 16);
                v[1] += __uint_as_float(c[0] & 0xffff0000u) + __uint_as_float(w[0] & 0xffff0000u);
                v[2] += __uint_as_float(c[1] << 16) + __uint_as_float(w[1] << 16);
                v[3] += __uint_as_float(c[1] & 0xffff0000u) + __uint_as_float(w[1] & 0xffff0000u);
                st_bf4(mix + (size_t)t * DM + 1024 + h * 128 + 4 * g + db * 32 + r4 * 8, v);
            }
        }
}

__device__ __forceinline__ void cmp_item(CPR P, LAS unsigned char* lds, int kvh, int qt) {
    const bfraw* z = (const bfraw*)(P.ws + WS_Z);
    bfraw* ocmp = (bfraw*)(P.ws + WS_XB);
    const float* gates = (const float*)(P.ws + WS_GATES);
    unsigned* selg = (unsigned*)(P.ws + WS_SEL);
    const bfraw* kc = (const bfraw*)(P.ws + WS_KC) + (size_t)kvh * 1024 * 128;
    const bfraw* vct = (const bfraw*)(P.ws + WS_VCT) + (size_t)kvh * 128 * 1024;
    const int tid = otid(), wave = tid >> 6, lane = tid & 63, ql = lane & 31, g = lane >> 5;
    const int q0 = qt * 64, t = q0 + wave * 8 + (ql >> 2), r = ql & 3, h = kvh * 4 + r;
    LAS float* tb4 = (LAS float*)(lds + F_TB);
    LAS float* impw = (LAS float*)(lds + F_IMP) + wave * 2048;
    __syncthreads();
    {
        const int hh = tid >> 7, d = tid & 127;
        const float* table = P.in[15];
        tb4[hh * 132 + d] = (table[t5_bucket(d) * 16 + 8 + kvh * 4 + hh] - table[31 * 16 + 8 + kvh * 4 + hh]) * LOG2E;
        if (d == 0) tb4[hh * 132 + 128] = 0.f;
    }
#pragma unroll
    for (int i = 0; i < 32; ++i) impw[i * 64 + lane] = 0.f;
    __syncthreads();
    bf16x8 qf[8];
    load_q128(qf, z + Z1_NQ + ((size_t)h * S + t) * 128, g);
    f32x16 O[4];
#pragma unroll
    for (int i = 0; i < 4; ++i) O[i] = (f32x16)(0.f);
    float m = NEG, l = 0.f;
    const int tmax = q0 + 63;
    const int tile_hi = tmax >= 31 ? ((tmax - 31) >> 4) >> 6 : -1;
    const float sl2 = 0.08838834764831845f * LOG2E;
    flash_loop<M_CMP, 128, false>(lds, kc, 128, vct, 1024, nullptr, 0, tile_hi, qf, t, q0 + wave * 8, q0 + wave * 8 + 7, sl2, tb4 + r * 132, 0.f, O, m, l, nullptr);
    l += __shfl_xor(l, 32);
    const bool valid = m > -1e29f;
    const float inv = valid ? 1.0f / l : 0.f;
    {
        const float sc = inv * gates[(size_t)t * 24 + h];
        bfraw* orow = ocmp + (size_t)t * 1024 + h * 128 + 4 * g;
#pragma unroll
        for (int db = 0; db < 4; ++db)
#pragma unroll
            for (int r4 = 0; r4 < 4; ++r4) {
                f32x4 v; v[0] = O[db][r4 * 4] * sc; v[1] = O[db][r4 * 4 + 1] * sc; v[2] = O[db][r4 * 4 + 2] * sc; v[3] = O[db][r4 * 4 + 3] * sc;
                if (!valid) v = (f32x4){0.f, 0.f, 0.f, 0.f};
                st_bf4(orow + db * 32 + r4 * 8, v);
            }
    }
    float m2 = valid ? m : 0.f, l2 = inv;
    flash_loop<M_CMP, 128, true>(lds, kc, 128, vct, 1024, nullptr, 0, tile_hi, qf, t, q0 + wave * 8, q0 + wave * 8 + 7, sl2, tb4 + r * 132, 0.f, O, m2, l2, impw);
    __syncthreads();
    {
        float sc[8][4]; unsigned sel[8];
#pragma unroll
        for (int qi = 0; qi < 8; ++qi) {
            const int tq = q0 + wave * 8 + qi, cur = tq >> 6;
            sel[qi] = 0u;
#pragma unroll
            for (int i = 0; i < 4; ++i) {
                const int jb = i * 64 + lane;
                const float imp = impw[qi * 256 + jb];
                const bool forced = (jb == 0) || (jb == cur) || (jb == cur - 1);
                sc[qi][i] = forced ? 1e9f : ((jb * 64 <= tq) ? imp : -1e9f);
            }
        }
        for (int it = 0; it < 16; ++it) {
            float bv[8]; int bj[8];
#pragma unroll
            for (int qi = 0; qi < 8; ++qi) {
                bv[qi] = -3e38f; bj[qi] = 1 << 20;
#pragma unroll
                for (int i = 0; i < 4; ++i) if (!((sel[qi] >> i) & 1u) && sc[qi][i] > bv[qi]) { bv[qi] = sc[qi][i]; bj[qi] = i * 64 + lane; }
            }
#pragma unroll
            for (int qi = 0; qi < 8; ++qi) wave_argmax(bv[qi], bj[qi]);
#pragma unroll
            for (int qi = 0; qi < 8; ++qi) if ((bj[qi] & 63) == lane) sel[qi] |= 1u << (bj[qi] >> 6);
        }
#pragma unroll
        for (int qi = 0; qi < 8; ++qi) {
            const int tq = q0 + wave * 8 + qi;
            unsigned long long b0 = __builtin_amdgcn_ballot_w64((sel[qi] & 1u) != 0), b1 = __builtin_amdgcn_ballot_w64((sel[qi] & 2u) != 0),
                               b2 = __builtin_amdgcn_ballot_w64((sel[qi] & 4u) != 0), b3 = __builtin_amdgcn_ballot_w64((sel[qi] & 8u) != 0);
            if (lane < 8) {
                const unsigned long long bb = (lane >> 1) == 0 ? b0 : ((lane >> 1) == 1 ? b1 : ((lane >> 1) == 2 ? b2 : b3));
                selg[((size_t)tq * 2 + kvh) * 8 + lane] = (lane & 1) ? (unsigned)(bb >> 32) : (unsigned)bb;
            }
        }
    }
}

__device__ __forceinline__ void cmp_mlp_item(CPR P, LAS unsigned char* lds, int kv, int kvh, int mt) {
    const bfraw* z = (const bfraw*)(P.ws + WS_Z); const bfraw* W = (const bfraw*)(P.ws + WS_W);
    const bfraw* src = z + (kv == 0 ? Z1_CK : Z1_CV) + (size_t)kvh * CKV_HS;
    const bfraw* w1t = W + W_C1 + (size_t)kv * 128 * 4096; const bfraw* w2t = W + W_C2 + (size_t)kv * 128 * 128;
    const float* pbias = (const float*)(P.ws + WS_PBIAS) + kv * 128;
    const int tid = otid(), w = tid >> 6, lane = tid & 63, ql = lane & 31, g = lane >> 5;
    LAS unsigned char* As = lds; LAS unsigned char* Bs = lds + 128 * T128;
    f32x16 acc[2]; acc[0] = (f32x16)(0.f); acc[1] = (f32x16)(0.f);
    for (int kc = 0; kc < 32; ++kc) {
        __syncthreads();
        stage128(As, src + (size_t)(mt * 128) * 2048 + kc * 128, 2048);
        stage128(Bs, w1t + kc * 128, 4096);
        __syncthreads();
        mm128(As, T128, Bs, T128, 128, acc);
    }
    __syncthreads();
#pragma unroll
    for (int nb = 0; nb < 2; ++nb)
#pragma unroll
        for (int r = 0; r < 16; ++r) {
            const int row = (w >> 1) * 32 + (r & 3) + 8 * (r >> 2) + 4 * g, col = (w & 1) * 64 + nb * 32 + ql;
            *(LAS bfraw*)(As + row * T128 + col * 2) = f2bf(siluf_(acc[nb][r] + pbias[col]));
        }
    stage128(Bs, w2t, 128);
    __syncthreads();
    acc[0] = (f32x16)(0.f); acc[1] = (f32x16)(0.f);
    mm128(As, T128, Bs, T128, 128, acc);
    bfraw* kcb = (bfraw*)(P.ws + WS_KC) + (size_t)kvh * 1024 * 128; bfraw* vcb = (bfraw*)(P.ws + WS_VCT) + (size_t)kvh * 128 * 1024;
#pragma unroll
    for (int nb = 0; nb < 2; ++nb)
#pragma unroll
        for (int r = 0; r < 16; ++r) {
            const int row = mt * 128 + (w >> 1) * 32 + (r & 3) + 8 * (r >> 2) + 4 * g, col = (w & 1) * 64 + nb * 32 + ql;
            const bfraw v = row < 1023 ? f2bf(acc[nb][r]) : (bfraw)0;
            if (kv == 0) kcb[(size_t)row * 128 + col] = v; else vcb[(size_t)col * 1024 + row] = v;
        }
}

constexpr int N_PHASES = 19;
#ifndef PH_MASK
#define PH_MASK 0x1FFFFFFu
#endif
#define PHON(n) (((PH_MASK) >> (n)) & 1u)
__device__ __forceinline__ void grid_barrier(unsigned* ctr, unsigned k, unsigned G) {
    __syncthreads();
    if (threadIdx.x == 0) {
        __builtin_amdgcn_fence(__ATOMIC_RELEASE, "agent");
        asm volatile("s_waitcnt vmcnt(0) lgkmcnt(0)" ::: "memory");
        const unsigned grp = blockIdx.x & 7u, gsize = (G - grp + 7u) >> 3;
        const unsigned old = __hip_atomic_fetch_add(ctr + 32 * grp, 1u, __ATOMIC_RELAXED, __HIP_MEMORY_SCOPE_AGENT);
        if (old + 1u == gsize * k) __hip_atomic_fetch_add(ctr + 32 * 8, 1u, __ATOMIC_RELAXED, __HIP_MEMORY_SCOPE_AGENT);
        const unsigned ngrp = G < 8u ? G : 8u;
        while (__hip_atomic_load(ctr + 32 * 8, __ATOMIC_RELAXED, __HIP_MEMORY_SCOPE_AGENT) < ngrp * k) __builtin_amdgcn_s_sleep(4);
        __builtin_amdgcn_fence(__ATOMIC_ACQUIRE, "agent");
        asm volatile("s_waitcnt vmcnt(0) lgkmcnt(0)" ::: "memory");
    }
    __syncthreads();
}
__device__ __forceinline__ int queue_pop(unsigned* qctr, LAS unsigned char* lds) {
    LAS int* slot = (LAS int*)(lds + LDS_BYTES - 64);
    __syncthreads();
    if (otid() == 0) slot[0] = (int)__hip_atomic_fetch_add(qctr, 1u, __ATOMIC_RELAXED, __HIP_MEMORY_SCOPE_AGENT);
    __syncthreads();
    return __builtin_amdgcn_readfirstlane(slot[0]);
}
template <int ph>
__device__ __forceinline__ void run_phase(LAS unsigned char* lds, int G, int bid, unsigned* bar_ctr, unsigned& nbar) {
        const __attribute__((address_space(4))) Params* Pp = (const __attribute__((address_space(4))) Params*)__builtin_amdgcn_kernarg_segment_ptr();
        asm volatile("" : "+s"(Pp));
        CPR P = *Pp;
        bfraw* W = (bfraw*)(P.ws + WS_W);
        bfraw* XB = (bfraw*)(P.ws + WS_XB); bfraw* Z = (bfraw*)(P.ws + WS_Z); bfraw* Mx = (bfraw*)(P.ws + WS_M); bfraw* PB = (bfraw*)(P.ws + WS_PB);
        float* ssq = (float*)(P.ws + WS_SSQ);
        switch (ph) {
        case 0: if (PHON(0)) { phase_conv(P, lds, 0); phase_prep(P); } break;
        case 1: if (PHON(1)) {
            pg8::Gemm gm; gm.A0 = XB; gm.Bt0 = W + W_IN; gm.A1 = W + W_IN + (size_t)5376 * DM; gm.Bt1 = XB; gm.K = DM;
            pg8::Sched2 sc; sc.init(S, 5120, 2048, S, G, bid);
            EpiZ e{(const float*)(P.ws + WS_RINV), Z, (float*)(P.ws + WS_FL), 0};
            pg8::gemm_phase(lds, gm, sc, e);
            fl_rows(P, lds);
        } break;
        case 2: if (PHON(2)) {
            unsigned* qctr = (unsigned*)(P.ws + WS_BAR) + 386;
            for (;;) {
                const int it = queue_pop(qctr, lds);
                if (it >= 8 + 64 + 1024) break;
                if (it < 8) fox_cumsum_item(P, lds, it);
                else if (it < 72) fox_kmax_item(P, lds, (it - 8) & 7, (it - 8) >> 3);
                else ret_upd_item(P, lds, (it - 72) >> 7, (it - 72) & 127);
            }
            }
            break;
        case 3: if (PHON(3)) phase_ret_scan(P); break;
        case 4: if (PHON(4)) {
            unsigned* qctr = (unsigned*)(P.ws + WS_BAR) + 384;
            LAS int* slot = (LAS int*)(lds + LDS_BYTES - 64);
            for (;;) {
                __syncthreads();
                if (otid() == 0) slot[0] = (int)__hip_atomic_fetch_add(qctr, 1u, __ATOMIC_RELAXED, __HIP_MEMORY_SCOPE_AGENT);
                __syncthreads();
                const int it = __builtin_amdgcn_readfirstlane(slot[0]);
                if (it >= 512 + 1024) break;
                if (it < 512) { if (PHON(22)) fox_item(P, lds, it & 7, 63 - (it >> 3)); }
                else { const int r = it - 512; if (PHON(21)) ret_out_item(P, lds, r >> 7, r & 127); }
            }
            }
            break;
        case 5: case 14: if (PHON(5)) {
            pg8::Gemm gm; gm.A0 = Mx; gm.Bt0 = W + W_OUT; gm.A1 = Mx; gm.Bt1 = W + W_OUT; gm.K = DM;
            pg8::Sched2 sc; sc.init(S, DM, 0, 0, G, bid);
            EpiRes e{ph == 5 ? P.in[0] : P.out, P.out, XB, ssq, 1};
            pg8::gemm_phase(lds, gm, sc, e);
        } break;
        case 6: case 15: if (PHON(6)) {
            {
                const int gt = bid * NTHREADS + otid();
                if (gt < S) ((float*)(P.ws + WS_RINV))[gt] = row_rinv(ssq, gt);
                nbar += 1u; grid_barrier(bar_ctr, nbar, (unsigned)G);
            }
            if (PHON(23)) {
                pg8::Gemm gm; gm.A0 = XB; gm.Bt0 = W + W_GU; gm.A1 = XB; gm.Bt1 = W + W_GU; gm.K = DM;
                pg8::Sched2 sc; sc.init(S, 2 * DFF, 0, 0, G, bid);
                EpiGU e{(const float*)(P.ws + WS_RINV), Z};
                pg8::gemm_phase(lds, gm, sc, e);
            }
            if (PHON(24)) {
                const bfraw* pbl = PB + (size_t)(ph == 6 ? 0 : 1) * S * PLE;
                pg8::Gemm gm; gm.A0 = pbl; gm.Bt0 = W + W_PP; gm.A1 = pbl; gm.Bt1 = W + W_PP; gm.K = PLE;
                pg8::Sched2 sc; sc.init(S, DM, 0, 0, G, bid);
                EpiPP e{Mx};
                pg8::gemm_phase(lds, gm, sc, e);
            }
        } break;
        case 7: case 16: if (PHON(7)) {
            pg8::Gemm gm; gm.A0 = Z; gm.Bt0 = W + W_D; gm.A1 = Z; gm.Bt1 = W + W_D; gm.K = DFF;
            pg8::Sched2 sc; sc.init(S, DM, 0, 0, G, bid);
            EpiRes e{P.out, P.out, XB, ssq, 0};
            pg8::gemm_phase(lds, gm, sc, e);
        } break;
        case 8: case 17: if (PHON(8)) {
            pg8::Gemm gm; gm.A0 = XB; gm.Bt0 = W + W_PG; gm.A1 = XB; gm.Bt1 = W + W_PG; gm.K = DM;
            pg8::Sched2 sc; sc.init(S, DM, 0, 0, G, bid);
            EpiPLE e{P.out, Mx, ssq};
            pg8::gemm_phase(lds, gm, sc, e);
        } break;
        case 9: if (PHON(9)) phase_conv(P, lds, 1); break;
        case 10: if (PHON(10)) {
            pg8::Gemm gm; gm.A0 = Mx; gm.Bt0 = W + W_IN; gm.A1 = W + W_IN + (size_t)4352 * DM; gm.Bt1 = Mx; gm.K = DM;
            pg8::Sched2 sc; sc.init(S, 4352, 1536, S, G, bid);
            EpiZ e{(const float*)(P.ws + WS_RINV), Z, (float*)(P.ws + WS_GATES), 1};
            pg8::gemm_phase(lds, gm, sc, e);
        } break;
        case 11: {
            if (PHON(11)) for (int it = bid; it < 32; it += G) cmp_mlp_item(P, lds, it >> 4, (it >> 3) & 1, it & 7);
            if (PHON(19)) for (int u = bid * 2; u < 512; u += (u & 1) ? 2 * G - 1 : 1) { const int h = (u >> 1) & 7, pr = u >> 4; diff_item(P, lds, h, (u & 1) ? pr : 63 - pr); }
            if (PHON(20)) {
                const int skip = G > 64 ? 32 : 0;
                if (bid >= skip) for (int it = bid - skip; it < 512; it += G - skip) nsa_item<M_WIN>(P, lds, it & 7, it >> 3);
            }
            } break;
        case 12: if (PHON(12)) {
            unsigned* qctr = (unsigned*)(P.ws + WS_BAR) + 388;
            for (;;) {
                const int it = queue_pop(qctr, lds);
                if (it >= 512) break;
                cmp_item(P, lds, it & 1, 255 - (it >> 1));
            }
            }
            break;
        case 13: if (PHON(13)) {
            unsigned* qctr = (unsigned*)(P.ws + WS_BAR) + 389;
            for (;;) {
                const int it = queue_pop(qctr, lds);
                if (it >= 512) break;
                nsa_item<M_SLC>(P, lds, it & 7, 63 - (it >> 3));
            }
            }
            break;
        case 18: if (PHON(18)) phase_final(P); break;
        default: break;
        }
}
#ifndef PROBE_REP
#define PROBE_REP 0u
#endif
#define GSYNC() do { nbar += 1u; grid_barrier(bar_ctr, nbar, (unsigned)G); } while (0)
#define RUN_PH(n) do { if ((n) >= ph_lo && (n) < ph_hi) { if ((n) != ph_lo) { GSYNC(); } run_phase<(n)>(lds, G, bid, bar_ctr, nbar); \
                       if ((PROBE_REP >> (n)) & 1u) { GSYNC(); run_phase<(n)>(lds, G, bid, bar_ctr, nbar); } } } while (0)
__global__ void __launch_bounds__(NTHREADS, 2) fwd_megakernel(Params P0) {
    extern __shared__ __attribute__((aligned(16))) unsigned char shm[];
    LAS unsigned char* lds = (LAS unsigned char*)shm;
    cg::grid_group grid = cg::this_grid();
    const int G = gridDim.x, bid = blockIdx.x;
    const int ph_lo = P0.ph_lo, ph_hi = P0.ph_hi;
    unsigned* bar_ctr = (unsigned*)(P0.ws + WS_BAR); unsigned nbar = 0u;
    if (ph_hi < 0) grid.sync();
    RUN_PH(0); RUN_PH(1); RUN_PH(2); RUN_PH(3); RUN_PH(4); RUN_PH(5); RUN_PH(6); RUN_PH(7); RUN_PH(8); RUN_PH(9);
    RUN_PH(10); RUN_PH(11); RUN_PH(12); RUN_PH(13); RUN_PH(14); RUN_PH(15); RUN_PH(16); RUN_PH(17); RUN_PH(18);
}

extern "C" void kernel_launch(void* const* d_in, const int* in_sizes, int n_in, void* d_out, int out_size, void* d_ws, size_t ws_size, hipStream_t stream) {
    static int grid_blocks = 0;
    if (!grid_blocks) {
        int dev = 0, cus = 0, per_cu = 0;
        hipGetDevice(&dev);
        hipDeviceGetAttribute(&cus, hipDeviceAttributeMultiprocessorCount, dev);
        hipFuncSetAttribute((const void*)fwd_megakernel, hipFuncAttributeMaxDynamicSharedMemorySize, LDS_BYTES);
        hipOccupancyMaxActiveBlocksPerMultiprocessor(&per_cu, (const void*)fwd_megakernel, NTHREADS, LDS_BYTES);
        if (per_cu < 1) per_cu = 1;
        grid_blocks = cus * 1;
        if (ws_size < WS_END) fprintf(stderr, "kernel_launch: workspace too small: %zu < %zu\n", ws_size, (size_t)WS_END);
        (void)hipGetLastError();
    }
    (void)hipMemsetAsync((char*)d_ws + WS_BAR, 0, 2048, stream);
    Params p{};
    for (int i = 0; i < 22 && i < n_in; ++i) p.in[i] = (const float*)d_in[i];
    p.out = (float*)d_out; p.ws = (unsigned char*)d_ws; p.ph_lo = 0; p.ph_hi = N_PHASES;
    void* args[] = {&p};
    hipError_t e = hipLaunchCooperativeKernel((const void*)fwd_megakernel, dim3(grid_blocks), dim3(NTHREADS), args, LDS_BYTES, stream);
    if (e != hipSuccess) fprintf(stderr, "cooperative launch failed: %s (grid %d)\n", hipGetErrorString(e), grid_blocks);
}
```

```cpp
#include <hip/hip_runtime.h>
#include <hip/hip_cooperative_groups.h>
#include <stdint.h>
#include <cstdio>
namespace cg = cooperative_groups;

#define LAS __attribute__((address_space(3)))
typedef unsigned short bfraw;
typedef short bf16x8 __attribute__((ext_vector_type(8)));
typedef float f32x4 __attribute__((ext_vector_type(4)));
typedef float f32x16 __attribute__((ext_vector_type(16)));
typedef unsigned u32x4 __attribute__((ext_vector_type(4)));
typedef unsigned u32x2 __attribute__((ext_vector_type(2)));

constexpr int S = 16384, DM = 2048, DFF = 5632, PLE = 256;
constexpr int EVEN_COLS = 7176, ODD_COLS = 5656;
constexpr float EPS = 1e-6f;
constexpr float LOG2E = 1.4426950408889634f;
constexpr float NEG = -1e30f;
constexpr float LINIT = 0.35550906759096934f;
constexpr int NTHREADS = 512;
constexpr int LDS_BYTES = 147456;

constexpr size_t WS_W = 0;
constexpr size_t W_IN = 0, W_OUT = 15204352, W_GU = 19398656, W_D = 42467328, W_PG = 54001664, W_PP = 58195968, W_C1 = 58720256, W_C2 = 59768832, W_END = 59801600;
constexpr size_t WS_XB = WS_W + W_END * 2;
constexpr size_t WS_Z = WS_XB + (size_t)S * DM * 2;
constexpr size_t WS_M = WS_Z + (size_t)S * 7168 * 2;
constexpr size_t WS_PB = WS_M + (size_t)S * DM * 2;
constexpr size_t WS_SSQ = WS_PB + (size_t)2 * S * PLE * 2;
constexpr size_t WS_FL = WS_SSQ + (size_t)S * 32 * 4;
constexpr size_t WS_C2 = WS_FL + (size_t)8 * S * 4;
constexpr size_t WS_GATES = WS_C2 + (size_t)8 * S * 4;
constexpr size_t WS_SEL = WS_GATES + (size_t)S * 24 * 4;
constexpr size_t WS_KC = WS_SEL + (size_t)S * 16 * 4;
constexpr size_t WS_VCT = WS_KC + (size_t)2 * 1024 * 128 * 2;
constexpr size_t WS_PBIAS = WS_VCT + (size_t)2 * 1024 * 128 * 2;
constexpr size_t WS_KMAX = WS_PBIAS + 2048;
constexpr size_t WS_BAR = WS_PBIAS + 4096;
constexpr size_t WS_RINV = WS_PBIAS + 8192;
constexpr size_t WS_END = WS_RINV + (size_t)S * 4;
constexpr size_t Z0_RQK = 0, Z0_RG = (size_t)2048 * S, Z0_FQK = (size_t)3072 * S, Z0_VT = (size_t)5120 * S;
constexpr size_t CKV_HS = (size_t)(S + 32) * 128;
constexpr size_t Z1_DQK = 0, Z1_NQ = (size_t)2048 * S, Z1_CK = (size_t)3072 * S, Z1_CV = Z1_CK + 2 * CKV_HS, Z1_SK = Z1_CV + 2 * CKV_HS,
                 Z1_WK = Z1_SK + (size_t)256 * S, Z1_VT = Z1_WK + (size_t)256 * S;

struct Params {
    const float* in[22];
    float* out;
    unsigned char* ws;
    int ph_lo, ph_hi;
};

typedef const __attribute__((address_space(4))) Params& CPR;
__device__ __forceinline__ int otid() { int t = threadIdx.x; asm volatile("" : "+v"(t)); return t; }
__device__ __forceinline__ unsigned short f2bf(float f) { unsigned u = __float_as_uint(f); u += 0x7fffu + ((u >> 16) & 1u); return (unsigned short)(u >> 16); }
__device__ __forceinline__ float bf2f(unsigned short b) { return __uint_as_float(((unsigned)b) << 16); }
__device__ __forceinline__ unsigned pack2(float lo, float hi) { unsigned r; asm volatile("v_cvt_pk_bf16_f32 %0, %1, %2" : "=v"(r) : "v"(lo), "v"(hi)); return r; }
__device__ __forceinline__ float fexp2(float x) { return __builtin_amdgcn_exp2f(x); }
template <int CTRL> __device__ __forceinline__ int dppi(int v) { return __builtin_amdgcn_update_dpp(v, v, CTRL, 0xF, 0xF, false); }
template <int CTRL> __device__ __forceinline__ float dppf(float v) { return __int_as_float(dppi<CTRL>(__float_as_int(v))); }
__device__ __forceinline__ void amax_merge(float& bv, int& bj, float ov, int oj) { if (ov > bv || (ov == bv && oj < bj)) { bv = ov; bj = oj; } }
__device__ __forceinline__ void wave_argmax(float& bv, int& bj) {
    typedef unsigned u2v __attribute__((ext_vector_type(2)));
    amax_merge(bv, bj, dppf<0xB1>(bv), dppi<0xB1>(bj));
    amax_merge(bv, bj, dppf<0x4E>(bv), dppi<0x4E>(bj));
    amax_merge(bv, bj, dppf<0x141>(bv), dppi<0x141>(bj));
    amax_merge(bv, bj, dppf<0x140>(bv), dppi<0x140>(bj));
    {
        const u2v rv = __builtin_amdgcn_permlane16_swap(__float_as_uint(bv), __float_as_uint(bv), false, false);
        const u2v rj = __builtin_amdgcn_permlane16_swap((unsigned)bj, (unsigned)bj, false, false);
        float av = __uint_as_float(rv[0]); int aj = (int)rj[0];
        amax_merge(av, aj, __uint_as_float(rv[1]), (int)rj[1]); bv = av; bj = aj;
    }
    {
        const u2v rv = __builtin_amdgcn_permlane32_swap(__float_as_uint(bv), __float_as_uint(bv), false, false);
        const u2v rj = __builtin_amdgcn_permlane32_swap((unsigned)bj, (unsigned)bj, false, false);
        float av = __uint_as_float(rv[0]); int aj = (int)rj[0];
        amax_merge(av, aj, __uint_as_float(rv[1]), (int)rj[1]); bv = av; bj = aj;
    }
}
__device__ __forceinline__ float xhalf_max(float x) {
    typedef unsigned u2v __attribute__((ext_vector_type(2)));
    const u2v r = __builtin_amdgcn_permlane32_swap(__float_as_uint(x), __float_as_uint(x), false, false);
    return fmaxf(__uint_as_float(r[0]), __uint_as_float(r[1]));
}
__device__ __forceinline__ float fmax3(float a, float b, float c) { float d; asm("v_max3_f32 %0, %1, %2, %3" : "=v"(d) : "v"(a), "v"(b), "v"(c)); return d; }
__device__ __forceinline__ float sigmoidf_(float x) { return __builtin_amdgcn_rcpf(1.0f + fexp2(-LOG2E * x)); }
__device__ __forceinline__ float siluf_(float x) { return x * __builtin_amdgcn_rcpf(1.0f + fexp2(-LOG2E * x)); }
__device__ __forceinline__ float wsum(float v) {
#pragma unroll
    for (int o = 32; o >= 1; o >>= 1) v += __shfl_xor(v, o);
    return v;
}
__device__ __forceinline__ float row_rinv(const float* ssq, int row) {
    const f32x4* p = (const f32x4*)(ssq + (size_t)row * 32);
    float s = 0.f;
#pragma unroll
    for (int i = 0; i < 8; ++i) { f32x4 v = p[i]; s += (v[0] + v[1]) + (v[2] + v[3]); }
    return rsqrtf(s * (1.0f / 2048.0f) + EPS);
}

namespace pg8 {
constexpr int BM = 256, BK = 64, HALF = 128, HTB = HALF * BK * 2, STAGE_BYTES = 8 * HTB, NXCD = 8, WGM = 8;
__device__ __forceinline__ int lds_byte(int r, int c) { const int st = (r >> 4) * 2 + (c >> 5), rr = r & 15, cc = c & 31, ob = rr * 64 + cc * 2; return st * 1024 + (ob ^ (((ob >> 9) & 1) << 5)); }
__device__ __forceinline__ void stage_rc(int b, int& R, int& C) { const int st = b / 1024, sb = b % 1024, swz = sb ^ (((sb >> 9) & 1) << 5); R = (st >> 1) * 16 + swz / 64; C = (st & 1) * 32 + (swz % 64) / 2; }
struct Unit { int pm, pn, job; };
struct Gemm { const bfraw* A0; const bfraw* A1; const bfraw* Bt0; const bfraw* Bt1; int K; };
struct Sched2 {
    int nM[2], nN[2], nwg[2], G, c;
    __device__ void init(int M0, int N0, int M1, int N1, int G_, int c_) { nM[0] = M0 / BM; nN[0] = N0 / BM; nwg[0] = nM[0] * nN[0]; nM[1] = M1 / BM; nN[1] = N1 / BM; nwg[1] = nM[1] * nN[1]; G = G_; c = c_; }
    __device__ __forceinline__ void map(int wgid, int j, Unit& u) const {
        const int nwgj = nwg[j], nMj = nM[j], nNj = nN[j];
        { const int q = nwgj / NXCD, r = nwgj % NXCD, xcd = wgid % NXCD, off = wgid / NXCD; wgid = (xcd < r ? xcd * (q + 1) : r * (q + 1) + (xcd - r) * q) + off; }
        const int nig = WGM * nNj, gid = wgid / nig, fm = gid * WGM, gsz = (nMj - fm) < WGM ? (nMj - fm) : WGM;
        u.pm = fm + ((wgid % nig) % gsz); u.pn = (wgid % nig) / gsz; u.job = j;
    }
    __device__ __forceinline__ bool next(int i, Unit& u) const {
        long L = (long)i * G + c;
        if (L < nwg[0]) { map((int)L, 0, u); return true; }
        L -= nwg[0];
        if (L < nwg[1]) { map((int)L, 1, u); return true; }
        return false;
    }
};

template <class Epi>
__device__ __forceinline__ void gemm_phase(LAS unsigned char* lds, const Gemm g, const Sched2& S_, const Epi& E) {
    const int tid = otid(), wid = __builtin_amdgcn_readfirstlane(tid >> 6), lane = tid & 63, wr = wid >> 2, wc = wid & 3, fr = lane & 15, fq = lane >> 4;
    const int K = g.K, nt = K / BK;
    unsigned voffA[2], voffB[2];
#pragma unroll
    for (int i = 0; i < 2; ++i) { int R, C; stage_rc(tid * 16 + i * 8192, R, C); voffA[i] = (unsigned)(R * K + C) * 2u; voffB[i] = voffA[i]; }
    const size_t kstep = (size_t)(BK * 2);
    const size_t hstep = (size_t)HALF * K * 2;
    const size_t tstep = 2 * hstep;
    const unsigned ldsw = (unsigned)wid * 1024u;
    const int aoff = lds_byte(wr * 64 + fr, fq * 8), boff = lds_byte(wc * 32 + fr, fq * 8);
#define PG8_SA(b, h) (((b) * 2 + (h)) * HTB)
#define PG8_SB(b, h) ((4 + (b) * 2 + (h)) * HTB)
#define PG8_STAGE(bufoff, gbase, voff) do { _Pragma("unroll") for (int _i = 0; _i < 2; ++_i) \
        __builtin_amdgcn_global_load_lds((const unsigned*)((const char*)(gbase) + (voff)[_i]), (LAS unsigned*)(lds + (bufoff) + ldsw + _i * 8192), 16, 0, 0); } while (0)
#define PG8_LDA(dst, b, h) do { _Pragma("unroll") for (int m = 0; m < 4; ++m) _Pragma("unroll") for (int k = 0; k < 2; ++k) dst[m][k] = *(const LAS bf16x8*)(lds + PG8_SA(b, h) + aoff + m * 2048 + k * 1024); } while (0)
#define PG8_LDB(dst, b, h) do { _Pragma("unroll") for (int n = 0; n < 2; ++n) _Pragma("unroll") for (int k = 0; k < 2; ++k) dst[n][k] = *(const LAS bf16x8*)(lds + PG8_SB(b, h) + boff + n * 2048 + k * 1024); } while (0)
#define PG8_MMA(ai, bj, At, Bt) do { __builtin_amdgcn_s_setprio(1); _Pragma("unroll") for (int m = 0; m < 4; ++m) _Pragma("unroll") for (int n = 0; n < 2; ++n) _Pragma("unroll") for (int k = 0; k < 2; ++k) \
        acc[ai][bj][m][n] = __builtin_amdgcn_mfma_f32_16x16x32_bf16(Bt[n][k], At[m][k], acc[ai][bj][m][n], 0, 0, 0); __builtin_amdgcn_s_setprio(0); } while (0)
#define PG8_WAIT_V(n) asm volatile("s_waitcnt vmcnt(" #n ")" ::: "memory")
#define PG8_WAIT_L(n) asm volatile("s_waitcnt lgkmcnt(" #n ")" ::: "memory")
#define PG8_BAR __builtin_amdgcn_s_barrier()
#define PG8_SCHED __builtin_amdgcn_sched_barrier(0)
    Unit cur, nxt; int ui = 0;
    if (!S_.next(0, cur)) return;
    f32x4 acc[2][2][4][2];
#pragma unroll
    for (int a = 0; a < 2; ++a)
#pragma unroll
        for (int b = 0; b < 2; ++b)
#pragma unroll
            for (int m = 0; m < 4; ++m)
#pragma unroll
                for (int n = 0; n < 2; ++n) acc[a][b][m][n] = (f32x4){0.f, 0.f, 0.f, 0.f};
    bf16x8 At[4][2], B0[2][2], B1[2][2];
    const char* cA = (const char*)(cur.job ? g.A1 : g.A0) + (size_t)cur.pm * tstep; const char* cB = (const char*)(cur.job ? g.Bt1 : g.Bt0) + (size_t)cur.pn * tstep;
    PG8_STAGE(PG8_SB(0, 0), cB, voffB); PG8_STAGE(PG8_SA(0, 0), cA, voffA); PG8_STAGE(PG8_SB(0, 1), cB + hstep, voffB); PG8_STAGE(PG8_SA(0, 1), cA + hstep, voffA);
    if (wr == 1) PG8_BAR;
    PG8_WAIT_V(4); PG8_BAR;
    PG8_STAGE(PG8_SB(1, 0), cB + kstep, voffB); PG8_STAGE(PG8_SA(1, 0), cA + kstep, voffA); PG8_STAGE(PG8_SB(1, 1), cB + hstep + kstep, voffB);
    PG8_WAIT_V(6); PG8_BAR;
    for (;;) {
        const bool has_next = S_.next(ui + 1, nxt);
        const char* nA = has_next ? (const char*)(nxt.job ? g.A1 : g.A0) + (size_t)nxt.pm * tstep : cA; const char* nB = has_next ? (const char*)(nxt.job ? g.Bt1 : g.Bt0) + (size_t)nxt.pn * tstep : cB;
        for (int t = 0; t < nt; t += 2) {
            const bool last = (t == nt - 2);
            const char* a1 = cA + (size_t)(t + 1) * kstep;
            const char* a2 = last ? nA : cA + (size_t)(t + 2) * kstep; const char* b2 = last ? nB : cB + (size_t)(t + 2) * kstep;
            const char* a3 = a2 + kstep; const char* b3 = b2 + kstep;
            PG8_LDB(B0, 0, 0); PG8_SCHED; PG8_LDA(At, 0, 0); PG8_STAGE(PG8_SA(1, 1), a1 + hstep, voffA);
            PG8_WAIT_L(8); PG8_BAR; PG8_WAIT_L(0); PG8_MMA(0, 0, At, B0); PG8_BAR; PG8_SCHED;
            PG8_LDB(B1, 0, 1); PG8_STAGE(PG8_SB(0, 0), b2, voffB);
            PG8_BAR; PG8_WAIT_L(0); PG8_MMA(0, 1, At, B1); PG8_BAR;
            PG8_LDA(At, 0, 1); PG8_STAGE(PG8_SA(0, 0), a2, voffA);
            PG8_BAR; PG8_WAIT_L(0); PG8_MMA(1, 0, At, B0); PG8_BAR; PG8_SCHED;
            PG8_STAGE(PG8_SB(0, 1), b2 + hstep, voffB);
            PG8_WAIT_V(6); PG8_BAR; PG8_MMA(1, 1, At, B1); PG8_BAR;
            PG8_LDB(B0, 1, 0); PG8_SCHED; PG8_LDA(At, 1, 0); PG8_STAGE(PG8_SA(0, 1), a2 + hstep, voffA);
            PG8_WAIT_L(8); PG8_BAR; PG8_WAIT_L(0); PG8_MMA(0, 0, At, B0); PG8_BAR; PG8_SCHED;
            PG8_LDB(B1, 1, 1); PG8_STAGE(PG8_SB(1, 0), b3, voffB);
            PG8_BAR; PG8_WAIT_L(0); PG8_MMA(0, 1, At, B1); PG8_BAR;
            PG8_LDA(At, 1, 1); PG8_STAGE(PG8_SA(1, 0), a3, voffA);
            PG8_BAR; PG8_WAIT_L(0); PG8_MMA(1, 0, At, B0); PG8_BAR; PG8_SCHED;
            PG8_STAGE(PG8_SB(1, 1), b3 + hstep, voffB);
            PG8_WAIT_V(6); PG8_BAR; PG8_MMA(1, 1, At, B1); PG8_BAR;
        }
        E(acc, cur, wr, wc, fr, fq);
        if (!has_next) break;
#pragma unroll
        for (int a = 0; a < 2; ++a)
#pragma unroll
            for (int b = 0; b < 2; ++b)
#pragma unroll
                for (int m = 0; m < 4; ++m)
#pragma unroll
                    for (int n = 0; n < 2; ++n) acc[a][b][m][n] = (f32x4){0.f, 0.f, 0.f, 0.f};
        cur = nxt; cA = nA; cB = nB; ++ui;
    }
    PG8_WAIT_V(0);
    if (wr == 0) PG8_BAR;
    PG8_BAR;
#undef PG8_SA
#undef PG8_SB
#undef PG8_STAGE
#undef PG8_LDA
#undef PG8_LDB
#undef PG8_MMA
#undef PG8_WAIT_V
#undef PG8_WAIT_L
#undef PG8_BAR
#undef PG8_SCHED
}
}
using pg8::Unit;
typedef f32x4 AccT[2][2][4][2];

__device__ __forceinline__ void st_bf4(bfraw* p, f32x4 v) { u32x2 o; o[0] = pack2(v[0], v[1]); o[1] = pack2(v[2], v[3]); *(u32x2*)p = o; }

struct EpiZ {
    const float* ssq; bfraw* z; float* aux; int layer;
    __device__ __forceinline__ void operator()(const AccT& acc, const Unit& u, int wr, int wc, int fr, int fq) const {
        if (u.job == 0) {
            size_t base; int c0, gc; size_t hs; int kind = 0;
            const int pn = u.pn;
            if (layer == 0) {
                if (pn < 8) { base = Z0_RQK; c0 = 0; gc = 128; hs = (size_t)S * 128; }
                else if (pn < 12) { base = Z0_RG; c0 = 2048; gc = 1024; hs = 0; }
                else if (pn < 20) { base = Z0_FQK; c0 = 3072; gc = 128; hs = (size_t)S * 128; }
                else { base = 0; c0 = 5120; gc = 1; hs = 0; kind = 1; }
            } else {
                if (pn < 8) { base = Z1_DQK; c0 = 0; gc = 64; hs = (size_t)S * 64; }
                else if (pn < 12) { base = Z1_NQ; c0 = 2048; gc = 128; hs = (size_t)S * 128; }
                else if (pn == 12) { base = Z1_CK; c0 = 3072; gc = 128; hs = CKV_HS; }
                else if (pn == 13) { base = Z1_CV; c0 = 3328; gc = 128; hs = CKV_HS; }
                else if (pn == 14) { base = Z1_SK; c0 = 3584; gc = 128; hs = (size_t)S * 128; }
                else if (pn == 15) { base = Z1_WK; c0 = 3840; gc = 128; hs = (size_t)S * 128; }
                else { base = 0; c0 = 4096; gc = 1; hs = 0; kind = 2; }
            }
            const int gsh = 31 - __builtin_clz((unsigned)gc);
#pragma unroll
            for (int ai = 0; ai < 2; ++ai) {
                float ri4[4];
#pragma unroll
                for (int m = 0; m < 4; ++m) ri4[m] = ssq[u.pm * 256 + ai * 128 + wr * 64 + m * 16 + fr];
#pragma unroll
                for (int m = 0; m < 4; ++m) {
                    const int row = u.pm * 256 + ai * 128 + wr * 64 + m * 16 + fr;
                    const float ri = ri4[m];
#pragma unroll
                    for (int bj = 0; bj < 2; ++bj)
#pragma unroll
                        for (int n = 0; n < 2; ++n) {
                            const int col = pn * 256 + bj * 128 + wc * 32 + n * 16 + fq * 4;
                            f32x4 v = acc[ai][bj][m][n] * ri;
                            const int cl = col - c0;
                            if (kind == 0) {
                                st_bf4(z + base + (size_t)(cl >> gsh) * hs + ((size_t)row << gsh) + (cl & (gc - 1)), v);
                            } else if (kind == 1) {
                                if (cl < 8) {
#pragma unroll
                                    for (int j = 0; j < 4; ++j) aux[(size_t)(cl + j) * S + row] = v[j];
                                }
                            } else {
                                if (cl < 24) {
#pragma unroll
                                    for (int j = 0; j < 4; ++j) aux[(size_t)row * 24 + cl + j] = sigmoidf_(v[j]);
                                }
                            }
                        }
                }
            }
        } else {
            bfraw* vt = z + (layer == 0 ? Z0_VT : Z1_VT);
            f32x4 rq4[4];
#pragma unroll
            for (int q = 0; q < 4; ++q) rq4[q] = *(const f32x4*)(ssq + u.pn * 256 + (q >> 1) * 128 + wc * 32 + (q & 1) * 16 + fq * 4);
#pragma unroll
            for (int bj = 0; bj < 2; ++bj)
#pragma unroll
                for (int n = 0; n < 2; ++n) {
                    const int col = u.pn * 256 + bj * 128 + wc * 32 + n * 16 + fq * 4;
                    const f32x4 ri = rq4[bj * 2 + n];
#pragma unroll
                    for (int ai = 0; ai < 2; ++ai)
#pragma unroll
                        for (int m = 0; m < 4; ++m) {
                            const int row = u.pm * 256 + ai * 128 + wr * 64 + m * 16 + fr;
                            st_bf4(vt + (size_t)row * S + col, acc[ai][bj][m][n] * ri);
                        }
                }
        }
    }
};

struct EpiRes {
    const float* xin; float* xout; bfraw* xb; float* ssq; int want_ssq;
    __device__ __forceinline__ void operator()(const AccT& acc, const Unit& u, int wr, int wc, int fr, int fq) const {
        const int row_b = u.pm * 256 + wr * 64 + fr, col_b = u.pn * 256 + wc * 32 + fq * 4;
        f32x4 xv[2][4];
#pragma unroll
        for (int q = 0; q < 4; ++q) xv[0][q] = *(const f32x4*)(xin + (size_t)row_b * DM + col_b + (q >> 1) * 128 + (q & 1) * 16);
#pragma unroll
        for (int bt = 0; bt < 8; ++bt) {
            const int ai = bt >> 2, m = bt & 3;
            const int row = row_b + ai * 128 + m * 16;
            if (bt + 1 < 8) {
                const int rown = row_b + ((bt + 1) >> 2) * 128 + ((bt + 1) & 3) * 16;
#pragma unroll
                for (int q = 0; q < 4; ++q) xv[(bt + 1) & 1][q] = *(const f32x4*)(xin + (size_t)rown * DM + col_b + (q >> 1) * 128 + (q & 1) * 16);
            }
            float part = 0.f;
#pragma unroll
            for (int q = 0; q < 4; ++q) {
                const int bj = q >> 1, n = q & 1;
                const size_t o = (size_t)row * DM + col_b + bj * 128 + n * 16;
                f32x4 v = xv[bt & 1][q] + acc[ai][bj][m][n];
                *(f32x4*)(xout + o) = v;
                st_bf4(xb + o, v);
                part += (v[0] * v[0] + v[1] * v[1]) + (v[2] * v[2] + v[3] * v[3]);
            }
            if (want_ssq) {
                part += __shfl_xor(part, 16); part += __shfl_xor(part, 32);
                if (fq == 0) ssq[(size_t)row * 32 + u.pn * 4 + wc] = part;
            }
        }
    }
};
struct EpiGU {
    const float* ssq; bfraw* act;
    __device__ __forceinline__ void operator()(const AccT& acc, const Unit& u, int wr, int wc, int fr, int fq) const {
#pragma unroll
        for (int ai = 0; ai < 2; ++ai) {
            float ri4[4];
#pragma unroll
            for (int m = 0; m < 4; ++m) ri4[m] = ssq[u.pm * 256 + ai * 128 + wr * 64 + m * 16 + fr];
#pragma unroll
            for (int m = 0; m < 4; ++m) {
                const int row = u.pm * 256 + ai * 128 + wr * 64 + m * 16 + fr;
                const float ri = ri4[m];
#pragma unroll
                for (int n = 0; n < 2; ++n) {
                    const int col = u.pn * 128 + wc * 32 + n * 16 + fq * 4;
                    f32x4 gt = acc[ai][0][m][n] * ri, up = acc[ai][1][m][n] * ri, r;
#pragma unroll
                    for (int j = 0; j < 4; ++j) r[j] = siluf_(gt[j]) * up[j];
                    st_bf4(act + (size_t)row * DFF + col, r);
                }
            }
        }
    }
};
struct EpiPP {
    bfraw* pp;
    __device__ __forceinline__ void operator()(const AccT& acc, const Unit& u, int wr, int wc, int fr, int fq) const {
#pragma unroll
        for (int ai = 0; ai < 2; ++ai)
#pragma unroll
            for (int m = 0; m < 4; ++m) {
                const int row = u.pm * 256 + ai * 128 + wr * 64 + m * 16 + fr;
#pragma unroll
                for (int bj = 0; bj < 2; ++bj)
#pragma unroll
                    for (int n = 0; n < 2; ++n) {
                        const int col = u.pn * 256 + bj * 128 + wc * 32 + n * 16 + fq * 4;
                        {
                            const f32x4 v = acc[ai][bj][m][n]; u32x2 o;
                            o[0] = (unsigned)f2bf(v[0]) | ((unsigned)f2bf(v[1]) << 16); o[1] = (unsigned)f2bf(v[2]) | ((unsigned)f2bf(v[3]) << 16);
                            *(u32x2*)(pp + (size_t)row * DM + col) = o;
                        }
                    }
            }
    }
};
struct EpiPLE {
    float* x; bfraw* pp; float* ssq;
    __device__ __forceinline__ void operator()(const AccT& acc, const Unit& u, int wr, int wc, int fr, int fq) const {
        const int row_b = u.pm * 256 + wr * 64 + fr, col_b = u.pn * 256 + wc * 32 + fq * 4;
#pragma unroll
        for (int bt = 0; bt < 8; ++bt) {
            const int ai = bt >> 2, m = bt & 3;
            const int row = row_b + ai * 128 + m * 16;
            f32x4 xv[4]; u32x2 pr[4];
#pragma unroll
            for (int q = 0; q < 4; ++q) {
                const size_t o = (size_t)row * DM + col_b + (q >> 1) * 128 + (q & 1) * 16;
                xv[q] = *(const f32x4*)(x + o); pr[q] = *(const u32x2*)(pp + o);
            }
            float part = 0.f;
#pragma unroll
            for (int q = 0; q < 4; ++q) {
                const int bj = q >> 1, n = q & 1;
                const size_t o = (size_t)row * DM + col_b + bj * 128 + n * 16;
                const f32x4 a = acc[ai][bj][m][n]; f32x4 v;
                v[0] = xv[q][0] + sigmoidf_(a[0]) * __uint_as_float(pr[q][0] << 16);
                v[1] = xv[q][1] + sigmoidf_(a[1]) * __uint_as_float(pr[q][0] & 0xffff0000u);
                v[2] = xv[q][2] + sigmoidf_(a[2]) * __uint_as_float(pr[q][1] << 16);
                v[3] = xv[q][3] + sigmoidf_(a[3]) * __uint_as_float(pr[q][1] & 0xffff0000u);
                *(f32x4*)(x + o) = v;
                st_bf4(pp + o, v);
                part += (v[0] * v[0] + v[1] * v[1]) + (v[2] * v[2] + v[3] * v[3]);
            }
            part += __shfl_xor(part, 16); part += __shfl_xor(part, 32);
            if (fq == 0) ssq[(size_t)row * 32 + u.pn * 4 + wc] = part;
        }
    }
};

__device__ __forceinline__ void conv_mat(LAS unsigned char* lds, const float* src, int ld_src, int K, int ncols, int ncols_pad, bfraw* dst, const float* gain, int blk, int off) {
    const int tid = otid();
    const int nk = K / 64, nn = ncols_pad / 64, ntiles = nk * nn, G = gridDim.x;
    const int lkk = tid >> 4, ln = (tid & 15) * 4;
    const int sn = tid >> 3, skg = tid & 7;
    f32x4 cur[2][2], nxt[2][2];
    auto load = [&](int t, f32x4 (&r)[2]) {
        const int k0 = (t % nk) * 64, n0 = (t / nk) * 64;
#pragma unroll
        for (int i = 0; i < 2; ++i) {
            const int kk = lkk + i * 32;
            f32x4 v = (f32x4){0.f, 0.f, 0.f, 0.f};
            if (t < ntiles && n0 + ln + 3 < ncols) { v = __builtin_nontemporal_load((const f32x4*)(src + (size_t)(k0 + kk) * ld_src + n0 + ln)); if (gain) v = v * gain[k0 + kk]; }
            r[i] = v;
        }
    };
    int t = blockIdx.x;
    if (t < ntiles) { load(t, cur[0]); load(t + G, cur[1]); }
    for (; t < ntiles; t += 2 * G) {
        const int tn = t + 2 * G;
        if (tn < ntiles) { load(tn, nxt[0]); load(tn + G, nxt[1]); }
        __syncthreads();
#pragma unroll
        for (int u = 0; u < 2; ++u) {
            LAS float* tile = (LAS float*)lds + u * (64 * 65);
#pragma unroll
            for (int i = 0; i < 2; ++i)
#pragma unroll
                for (int j = 0; j < 4; ++j) tile[(lkk + i * 32) * 65 + ln + j] = cur[u][i][j];
        }
        __syncthreads();
#pragma unroll
        for (int u = 0; u < 2; ++u) {
            const int tt = t + u * G;
            if (tt < ntiles) {
                const LAS float* tile = (const LAS float*)lds + u * (64 * 65);
                const int k0 = (tt % nk) * 64, n0 = (tt / nk) * 64;
                const int nglob = n0 + sn;
                const int drow = blk ? (nglob / blk) * (2 * blk) + off + (nglob % blk) : nglob;
                u32x4 o;
#pragma unroll
                for (int j = 0; j < 4; ++j) o[j] = pack2(tile[(skg * 8 + 2 * j) * 65 + sn], tile[(skg * 8 + 2 * j + 1) * 65 + sn]);
                *(u32x4*)(dst + (size_t)drow * K + k0 + skg * 8) = o;
            }
        }
#pragma unroll
        for (int u = 0; u < 2; ++u) { cur[u][0] = nxt[u][0]; cur[u][1] = nxt[u][1]; }
    }
    __syncthreads();
}

__device__ __forceinline__ void phase_conv(CPR P, LAS unsigned char* lds, int layer) {
    bfraw* W = (bfraw*)(P.ws + WS_W);
    const float* nm = P.in[2] + layer * DM; const float* nf = P.in[3] + layer * DM;
    if (layer == 0) {
        const float* wi = P.in[4];
        conv_mat(lds, wi + 0, EVEN_COLS, DM, 2048, 2048, W + W_IN, nm, 0, 0);
        conv_mat(lds, wi + 3072, EVEN_COLS, DM, 3072, 3072, W + W_IN + (size_t)2048 * DM, nm, 0, 0);
        conv_mat(lds, wi + 7168, EVEN_COLS, DM, 8, 256, W + W_IN + (size_t)5120 * DM, nm, 0, 0);
        conv_mat(lds, wi + 2048, EVEN_COLS, DM, 1024, 1024, W + W_IN + (size_t)5376 * DM, nm, 0, 0);
        conv_mat(lds, wi + 6144, EVEN_COLS, DM, 1024, 1024, W + W_IN + (size_t)6400 * DM, nm, 0, 0);
        conv_mat(lds, P.in[7], DM, DM, DM, DM, W + W_OUT, nullptr, 0, 0);
    } else {
        const float* wi = P.in[8];
        conv_mat(lds, wi + 0, ODD_COLS, DM, 2048, 2048, W + W_IN, nm, 0, 0);
        conv_mat(lds, wi + 3072, ODD_COLS, DM, 1792, 1792, W + W_IN + (size_t)2048 * DM, nm, 0, 0);
        conv_mat(lds, wi + 5120, ODD_COLS, DM, 256, 256, W + W_IN + (size_t)3840 * DM, nm, 0, 0);
        conv_mat(lds, wi + 5632, ODD_COLS, DM, 24, 256, W + W_IN + (size_t)4096 * DM, nm, 0, 0);
        conv_mat(lds, wi + 2048, ODD_COLS, DM, 1024, 1024, W + W_IN + (size_t)4352 * DM, nm, 0, 0);
        conv_mat(lds, wi + 4864, ODD_COLS, DM, 256, 256, W + W_IN + (size_t)5376 * DM, nm, 0, 0);
        conv_mat(lds, wi + 5376, ODD_COLS, DM, 256, 256, W + W_IN + (size_t)5632 * DM, nm, 0, 0);
        conv_mat(lds, P.in[14], DM, DM, DM, DM, W + W_OUT, nullptr, 0, 0);
        for (int kv = 0; kv < 2; ++kv) {
            conv_mat(lds, P.in[12] + (size_t)kv * 4096 * 128, 128, 4096, 128, 128, W + W_C1 + (size_t)kv * 128 * 4096, nullptr, 0, 0);
            conv_mat(lds, P.in[13] + (size_t)kv * 128 * 128, 128, 128, 128, 128, W + W_C2 + (size_t)kv * 128 * 128, nullptr, 0, 0);
        }
        {
            const int tid = otid(), wave = tid >> 6, lane = tid & 63;
            for (int o = blockIdx.x * 8 + wave; o < 256; o += gridDim.x * 8) {
                const int kv = o >> 7, e = o & 127;
                const float* pos = P.in[11] + (size_t)kv * 4096; const float* w1 = P.in[12] + (size_t)kv * 4096 * 128;
                float s = 0.f;
#pragma unroll 16
                for (int j = 0; j < 64; ++j) { const int i = lane + 64 * j; s += pos[i] * w1[(size_t)i * 128 + e]; }
                s = wsum(s);
                if (lane == 0) ((float*)(P.ws + WS_PBIAS))[o] = s;
            }
        }
        {
            const int gt = blockIdx.x * NTHREADS + otid();
            if (gt < S) ((float*)(P.ws + WS_RINV))[gt] = row_rinv((const float*)(P.ws + WS_SSQ), gt);
        }
        {
            bfraw* z = (bfraw*)(P.ws + WS_Z);
            const int gt = blockIdx.x * NTHREADS + otid();
            if (gt < 4 * 32 * 128) {
                const int which = gt / (32 * 128), rem = gt % (32 * 128);
                const size_t b = (which < 2 ? Z1_CK : Z1_CV) + (size_t)(which & 1) * CKV_HS + (size_t)S * 128 + rem;
                z[b] = 0;
            }
        }
    }
    const int l = layer;
    conv_mat(lds, P.in[16] + (size_t)l * DM * DFF, DFF, DM, DFF, DFF, W + W_GU, nf, 128, 0);
    conv_mat(lds, P.in[17] + (size_t)l * DM * DFF, DFF, DM, DFF, DFF, W + W_GU, nf, 128, 128);
    conv_mat(lds, P.in[18] + (size_t)l * DFF * DM, DM, DFF, DM, DM, W + W_D, nullptr, 0, 0);
    conv_mat(lds, P.in[19] + (size_t)l * DM * DM, DM, DM, DM, DM, W + W_PG, nullptr, 0, 0);
    conv_mat(lds, P.in[20] + (size_t)l * PLE * DM, DM, PLE, DM, DM, W + W_PP, nullptr, 0, 0);
}

__device__ __forceinline__ void phase_prep(CPR P) {
    const int tid = otid(), wave = tid >> 6, lane = tid & 63;
    const float* x = P.in[0]; bfraw* xb = (bfraw*)(P.ws + WS_XB); float* ssq = (float*)(P.ws + WS_SSQ);
    for (int row = blockIdx.x * 8 + wave; row < S; row += gridDim.x * 8) {
        float s = 0.f;
#pragma unroll
        for (int i = 0; i < 8; ++i) {
            const size_t o = (size_t)row * DM + i * 256 + lane * 4;
            f32x4 v = __builtin_nontemporal_load((const f32x4*)(x + o));
            s += (v[0] * v[0] + v[1] * v[1]) + (v[2] * v[2] + v[3] * v[3]);
            st_bf4(xb + o, v);
        }
        s = wsum(s);
        if (lane < 32) ssq[(size_t)row * 32 + lane] = lane == 0 ? s : 0.f;
        if (lane == 0) ((float*)(P.ws + WS_RINV))[row] = rsqrtf(s * (1.0f / 2048.0f) + EPS);
    }
    if (blockIdx.x == 0 && tid < 8) ((unsigned*)(P.ws + WS_KMAX))[tid] = 0u;
    const float* p = P.in[1]; bfraw* pb = (bfraw*)(P.ws + WS_PB);
    const size_t n4 = (size_t)2 * S * PLE / 4;
    for (size_t i = (size_t)blockIdx.x * NTHREADS + tid; i < n4; i += (size_t)gridDim.x * NTHREADS) st_bf4(pb + i * 4, __builtin_nontemporal_load((const f32x4*)(p + i * 4)));
}

__device__ __forceinline__ void phase_final(CPR P) {
    const int tid = otid(), wave = tid >> 6, lane = tid & 63;
    float* x = P.out; const float* ssq = (const float*)(P.ws + WS_SSQ); const float* g = P.in[21];
    for (int row = blockIdx.x * 8 + wave; row < S; row += gridDim.x * 8) {
        const float ri = row_rinv(ssq, row);
#pragma unroll
        for (int i = 0; i < 8; ++i) {
            const size_t o = (size_t)row * DM + i * 256 + lane * 4;
            f32x4 v = *(const f32x4*)(x + o), gv = *(const f32x4*)(g + i * 256 + lane * 4);
            *(f32x4*)(x + o) = v * ri * gv;
        }
    }
}

__device__ __forceinline__ void fl_rows(CPR P, LAS unsigned char* lds) {
    const bfraw* xb = (const bfraw*)(P.ws + WS_XB); const bfraw* wfl = (const bfraw*)(P.ws + WS_W) + W_IN + (size_t)5120 * DM;
    const float* ssq = (const float*)(P.ws + WS_SSQ); float* fl = (float*)(P.ws + WS_FL);
    const int tid = otid(), wave = tid >> 6, lane = tid & 63;
    __syncthreads();
#pragma unroll
    for (int i = 0; i < 4; ++i) { const int c = tid + i * 512; *(LAS u32x4*)(lds + c * 16) = *(const u32x4*)(wfl + (size_t)c * 8); }
    __syncthreads();
    for (int row = blockIdx.x * 8 + wave; row < S; row += gridDim.x * 8) {
        float xv[32];
#pragma unroll
        for (int q = 0; q < 4; ++q) {
            const u32x4 v = *(const u32x4*)(xb + (size_t)row * DM + lane * 32 + q * 8);
#pragma unroll
            for (int e = 0; e < 4; ++e) { xv[q * 8 + 2 * e] = __uint_as_float(v[e] << 16); xv[q * 8 + 2 * e + 1] = __uint_as_float(v[e] & 0xffff0000u); }
        }
        float acc[8];
#pragma unroll
        for (int j = 0; j < 8; ++j) {
            float a = 0.f;
#pragma unroll
            for (int q = 0; q < 4; ++q) {
                const u32x4 w = *(const LAS u32x4*)(lds + j * 4096 + lane * 64 + q * 16);
#pragma unroll
                for (int e = 0; e < 4; ++e) { a += xv[q * 8 + 2 * e] * __uint_as_float(w[e] << 16); a += xv[q * 8 + 2 * e + 1] * __uint_as_float(w[e] & 0xffff0000u); }
            }
            acc[j] = wsum(a);
            __builtin_amdgcn_sched_barrier(0);
        }
        const float ri = ((const float*)(P.ws + WS_RINV))[row];
        if (lane < 8) {
            float v = acc[0];
#pragma unroll
            for (int j = 1; j < 8; ++j) v = (lane == j) ? acc[j] : v;
            fl[(size_t)lane * S + row] = v * ri;
        }
    }
    __syncthreads();
}

__device__ __forceinline__ void mm128(const LAS unsigned char* A, int astr, const LAS unsigned char* B, int bstr, int Kdim, f32x16 (&acc)[2]) {
    const int tid = otid(), w = tid >> 6, lane = tid & 63, ql = lane & 31, g = lane >> 5;
    const LAS unsigned char* ap = A + ((w >> 1) * 32 + ql) * astr + g * 16;
    const LAS unsigned char* bp0 = B + ((w & 1) * 64 + ql) * bstr + g * 16;
    const LAS unsigned char* bp1 = bp0 + 32 * bstr;
    (void)Kdim;
    bf16x8 a = *(const LAS bf16x8*)(ap), b0 = *(const LAS bf16x8*)(bp0), b1 = *(const LAS bf16x8*)(bp1);
#pragma unroll
    for (int kk = 0; kk < 8; ++kk) {
        bf16x8 na = a, nb0 = b0, nb1 = b1;
        if (kk + 1 < 8) { na = *(const LAS bf16x8*)(ap + (kk + 1) * 32); nb0 = *(const LAS bf16x8*)(bp0 + (kk + 1) * 32); nb1 = *(const LAS bf16x8*)(bp1 + (kk + 1) * 32); }
        __builtin_amdgcn_sched_barrier(0);
        acc[0] = __builtin_amdgcn_mfma_f32_32x32x16_bf16(a, b0, acc[0], 0, 0, 0);
        acc[1] = __builtin_amdgcn_mfma_f32_32x32x16_bf16(a, b1, acc[1], 0, 0, 0);
        __builtin_amdgcn_sched_barrier(0);
        a = na; b0 = nb0; b1 = nb1;
    }
}
constexpr int T128 = 272;
__device__ __forceinline__ void stage128(LAS unsigned char* dst, const bfraw* src, size_t ld) {
    const int tid = otid();
#pragma unroll
    for (int i = 0; i < 4; ++i) { const int c = tid + i * 512, row = c >> 4, col = c & 15; *(LAS u32x4*)(dst + row * T128 + col * 16) = *(const u32x4*)(src + (size_t)row * ld + col * 8); }
}
__device__ __forceinline__ float lgam2_of(int h) { return log1pf(-exp2f(-5.0f - (float)h)) * LOG2E; }

__device__ __forceinline__ void ret_upd_item(CPR P, LAS unsigned char* lds, int h, int n) {
    const bfraw* z = (const bfraw*)(P.ws + WS_Z); float* st = (float*)(P.ws + WS_XB);
    const int tid = otid();
    const float lg = lgam2_of(h);
    __syncthreads();
    stage128(lds, z + Z0_VT + (size_t)(h * 128) * S + n * 128, S);
    LAS unsigned char* B = lds + 128 * T128;
    const bfraw* kp = z + Z0_RQK + ((size_t)(8 + h) * S + n * 128) * 128;
#pragma unroll
    for (int i = 0; i < 4; ++i) {
        const int c = tid + i * 512, s = c >> 4, col = c & 15;
        const u32x4 v = *(const u32x4*)(kp + (size_t)s * 128 + col * 8);
        const float kw = fexp2(lg * (float)(127 - s)) * 0.08838834764831845f;
#pragma unroll
        for (int j = 0; j < 4; ++j) {
            const float lo = __uint_as_float(v[j] << 16) * kw, hi = __uint_as_float(v[j] & 0xffff0000u) * kw;
            *(LAS bfraw*)(B + (col * 8 + 2 * j) * T128 + s * 2) = f2bf(lo);
            *(LAS bfraw*)(B + (col * 8 + 2 * j + 1) * T128 + s * 2) = f2bf(hi);
        }
    }
    __syncthreads();
    f32x16 acc[2]; acc[0] = (f32x16)(0.f); acc[1] = (f32x16)(0.f);
    mm128(lds, T128, B, T128, 128, acc);
    const int w = tid >> 6, lane = tid & 63, ql = lane & 31, g = lane >> 5;
    float* o = st + ((size_t)(h * 128 + n) * 128) * 128;
#pragma unroll
    for (int nb = 0; nb < 2; ++nb)
#pragma unroll
        for (int r = 0; r < 16; ++r) {
            const int row = (w >> 1) * 32 + (r & 3) + 8 * (r >> 2) + 4 * g, col = (w & 1) * 64 + nb * 32 + ql;
            o[(size_t)row * 128 + col] = acc[nb][r];
        }
}
__device__ __forceinline__ void phase_ret_scan(CPR P) {
    float* st = (float*)(P.ws + WS_XB);
    for (int e = blockIdx.x * NTHREADS + otid(); e < 8 * 16384; e += gridDim.x * NTHREADS) {
        const int h = e >> 14, idx = e & 16383;
        const float decay = fexp2(lgam2_of(h) * 128.0f);
        float* p = st + (size_t)h * 128 * 16384 + idx;
        float state = 0.f;
        for (int n = 0; n < 128; n += 8) {
            float u[8];
#pragma unroll
            for (int i = 0; i < 8; ++i) u[i] = p[(size_t)(n + i) * 16384];
#pragma unroll
            for (int i = 0; i < 8; ++i) { p[(size_t)(n + i) * 16384] = state; state = state * decay + u[i]; }
        }
    }
}
__device__ __forceinline__ void ret_out_item(CPR P, LAS unsigned char* lds, int h, int n) {
    const bfraw* z = (const bfraw*)(P.ws + WS_Z); const float* st = (const float*)(P.ws + WS_XB); bfraw* mix = (bfraw*)(P.ws + WS_M);
    const int tid = otid(), w = tid >> 6, lane = tid & 63, ql = lane & 31, g = lane >> 5;
    const float lg = lgam2_of(h);
    LAS unsigned char* Qs = lds; LAS unsigned char* Ks = lds + 128 * T128; LAS unsigned char* Vs = lds + 2 * 128 * T128; LAS unsigned char* Xs = lds + 3 * 128 * T128;
    __syncthreads();
    stage128(Qs, z + Z0_RQK + ((size_t)h * S + n * 128) * 128, 128);
    stage128(Ks, z + Z0_RQK + ((size_t)(8 + h) * S + n * 128) * 128, 128);
    stage128(Vs, z + Z0_VT + (size_t)(h * 128) * S + n * 128, S);
    {
        const float* sp = st + ((size_t)(h * 128 + n) * 128) * 128;
#pragma unroll
        for (int i = 0; i < 8; ++i) {
            const int c = tid + i * 512, row = c >> 5, col = c & 31;
            const f32x4 v = *(const f32x4*)(sp + (size_t)row * 128 + col * 4);
            u32x2 o; o[0] = pack2(v[0], v[1]); o[1] = pack2(v[2], v[3]);
            *(LAS u32x2*)(Xs + row * T128 + col * 8) = o;
        }
    }
    __syncthreads();
    f32x16 accY[2], accA[2];
    accY[0] = (f32x16)(0.f); accY[1] = (f32x16)(0.f); accA[0] = (f32x16)(0.f); accA[1] = (f32x16)(0.f);
    mm128(Qs, T128, Xs, T128, 128, accY);
    mm128(Qs, T128, Ks, T128, 128, accA);
#pragma unroll
    for (int nb = 0; nb < 2; ++nb)
#pragma unroll
        for (int r = 0; r < 16; ++r) {
            const int c = (w >> 1) * 32 + (r & 3) + 8 * (r >> 2) + 4 * g, col = (w & 1) * 64 + nb * 32 + ql;
            accY[nb][r] *= fexp2(lg * (float)(c + 1));
            const int rel = c - col;
            accA[nb][r] = rel >= 0 ? accA[nb][r] * 0.08838834764831845f * fexp2(lg * (float)rel) : 0.f;
        }
    __syncthreads();
#pragma unroll
    for (int nb = 0; nb < 2; ++nb)
#pragma unroll
        for (int r = 0; r < 16; ++r) {
            const int c = (w >> 1) * 32 + (r & 3) + 8 * (r >> 2) + 4 * g, col = (w & 1) * 64 + nb * 32 + ql;
            *(LAS bfraw*)(Xs + c * T128 + col * 2) = f2bf(accA[nb][r]);
        }
    __syncthreads();
    mm128(Xs, T128, Vs, T128, 128, accY);
    __syncthreads();
    LAS float* Ys = (LAS float*)lds;
#pragma unroll
    for (int nb = 0; nb < 2; ++nb)
#pragma unroll
        for (int r = 0; r < 16; ++r) {
            const int c = (w >> 1) * 32 + (r & 3) + 8 * (r >> 2) + 4 * g, col = (w & 1) * 64 + nb * 32 + ql;
            Ys[c * 132 + col] = accY[nb][r];
        }
    __syncthreads();
    const float* gn = P.in[5];
    const bfraw* rg = z + Z0_RG;
    bfraw gq0[16], gq1[16];
#pragma unroll
    for (int i = 0; i < 16; ++i) { const int t = n * 128 + w * 16 + i; gq0[i] = rg[(size_t)t * 1024 + h * 128 + lane]; gq1[i] = rg[(size_t)t * 1024 + h * 128 + 64 + lane]; }
    const float gn0 = gn[h * 128 + lane], gn1 = gn[h * 128 + 64 + lane];
#pragma unroll
    for (int i = 0; i < 16; ++i) {
        const int c = w * 16 + i, t = n * 128 + c;
        const float v0 = Ys[c * 132 + lane], v1 = Ys[c * 132 + 64 + lane];
        const float mean = wsum(v0 + v1) * (1.0f / 128.0f);
        const float d0 = v0 - mean, d1 = v1 - mean;
        const float var = wsum(d0 * d0 + d1 * d1) * (1.0f / 128.0f);
        const float rstd = rsqrtf(var + EPS);
        const float g0 = bf2f(gq0[i]), g1 = bf2f(gq1[i]);
        mix[(size_t)t * DM + h * 128 + lane] = f2bf(d0 * rstd * gn0 * siluf_(g0));
        mix[(size_t)t * DM + h * 128 + 64 + lane] = f2bf(d1 * rstd * gn1 * siluf_(g1));
    }
}
__device__ __forceinline__ void fox_cumsum_item(CPR P, LAS unsigned char* lds, int h) {
    const float* fl = (const float*)(P.ws + WS_FL) + (size_t)h * S; float* c2 = (float*)(P.ws + WS_C2) + (size_t)h * S;
    const float fb = P.in[6][h];
    const int tid = otid();
    LAS double* sc = (LAS double*)lds;
    __syncthreads();
    float ls[32]; double tot = 0.0;
#pragma unroll
    for (int i = 0; i < 32; ++i) { const float x = fl[tid * 32 + i] + fb; ls[i] = fminf(x, 0.f) - log1pf(__expf(-fabsf(x))); tot += (double)ls[i]; }
    sc[tid] = tot;
    __syncthreads();
    for (int off = 1; off < 512; off <<= 1) {
        double v = tid >= off ? sc[tid - off] : 0.0;
        __syncthreads();
        sc[tid] += v;
        __syncthreads();
    }
    double run = sc[tid] - tot;
#pragma unroll
    for (int i = 0; i < 32; ++i) { run += (double)ls[i]; c2[tid * 32 + i] = (float)(run * 1.4426950408889634); }
    __syncthreads();
}

__device__ __forceinline__ void fox_kmax_item(CPR P, LAS unsigned char* lds, int h, int c) {
    const bfraw* k = (const bfraw*)(P.ws + WS_Z) + Z0_FQK + ((size_t)(8 + h) * S + (size_t)c * 2048) * 128;
    const int tid = otid();
    float mx = 0.f;
    for (int i = 0; i < 4; ++i) {
        const bfraw* row = k + (size_t)(tid * 4 + i) * 128;
        float s = 0.f;
#pragma unroll
        for (int q = 0; q < 16; ++q) {
            const u32x4 v = *(const u32x4*)(row + q * 8);
#pragma unroll
            for (int e = 0; e < 4; ++e) { const float lo = __uint_as_float(v[e] << 16), hi = __uint_as_float(v[e] & 0xffff0000u); s += lo * lo + hi * hi; }
        }
        mx = fmaxf(mx, s);
    }
#pragma unroll
    for (int o = 32; o >= 1; o >>= 1) mx = fmaxf(mx, __shfl_xor(mx, o));
    if ((tid & 63) == 0) atomicMax((unsigned*)(P.ws + WS_KMAX) + h, __float_as_uint(mx));
}

constexpr int F_KB0 = 0, F_KBS = 17408, F_VB0 = 34816, F_VBS = 18432, F_CT = 71680, F_TB = 72192, F_UN = 74304, F_IMP = 74752;
enum { M_FOX = 0, M_DIFF = 1, M_WIN = 2, M_SLC = 3, M_CMP = 4 };
__device__ __forceinline__ f32x16 mfma32(bf16x8 a, bf16x8 b, f32x16 c) { return __builtin_amdgcn_mfma_f32_32x32x16_bf16(a, b, c, 0, 0, 0); }
__device__ __forceinline__ int t5_bucket(int d) {
    if (d < 16) return d;
    int b = 16 + (int)(logf((float)d / 16.0f) / 2.0794415416798357f * 16.0f);
    return b < 31 ? b : 31;
}
__device__ __forceinline__ void build_t5(LAS float* tb, const float* table, int col) {
    const int d = otid();
    if (d <= 128) tb[d] = (table[t5_bucket(d) * 16 + col] - table[31 * 16 + col]) * LOG2E;
}
__device__ __forceinline__ int next_sel(const LAS unsigned* un, int j, int hi) {
    int jj = j + 1;
    if (jj > hi) return hi + 1;
    int w = jj >> 5; unsigned mask = un[w] & (~0u << (jj & 31));
    for (;;) {
        if (mask) { const int r = w * 32 + __ffs(mask) - 1; return r <= hi ? r : hi + 1; }
        ++w; if (w > (hi >> 5)) return hi + 1;
        mask = un[w];
    }
}

template <int DK> struct StageRegs { u32x4 k[DK == 128 ? 2 : 1]; u32x4 v[2]; float c; };

template <int MODE, int DK, bool PASS2>
__device__ __forceinline__ void flash_loop(LAS unsigned char* lds, const bfraw* Kg, int k_ld, const bfraw* Vtg, int vt_ld, const float* cg2,
                                           int tile_lo, int tile_hi, const bf16x8 (&qf)[DK / 16], int t_lane, int t_wmin, int t_wmax, float sl2,
                                           const LAS float* tb, float qnb,
                                           f32x16 (&O)[4], float& m_run, float& l_run, LAS float* impw) {
    constexpr int KSTR = DK * 2 + 16;
    const int tid = otid(), lane = tid & 63, ql = lane & 31, g = lane >> 5;
    const int prow = (ql & 19) | ((ql & 4) << 1) | ((ql & 8) >> 1);
    const LAS unsigned* un = (const LAS unsigned*)(lds + F_UN);
    const float rsl2 = 1.0f / sl2;
    StageRegs<DK> sr;
    auto load_tile = [&](int j) {
        const int kv0 = j * 64;
        if (DK == 128) {
#pragma unroll
            for (int i = 0; i < 2; ++i) { const int c = tid + i * 512, row = c >> 4, col = c & 15; sr.k[i] = *(const u32x4*)((const char*)Kg + (unsigned)(((kv0 + row) * k_ld + col * 8) * 2)); }
        } else {
            const int row = tid >> 3, col = tid & 7; sr.k[0] = *(const u32x4*)((const char*)Kg + (unsigned)(((kv0 + row) * k_ld + col * 8) * 2));
        }
        if (!PASS2) {
#pragma unroll
            for (int i = 0; i < 2; ++i) { const int c = tid + i * 512, row = c >> 3, col = c & 7; sr.v[i] = *(const u32x4*)((const char*)Vtg + (unsigned)((row * vt_ld + kv0 + col * 8) * 2)); }
        }
        if (MODE == M_FOX) { if (tid < 64) sr.c = cg2[kv0 + tid]; }
    };
    auto write_tile = [&](int buf) {
        if (DK == 128) {
#pragma unroll
            for (int i = 0; i < 2; ++i) { const int c = tid + i * 512, row = c >> 4, col = c & 15; *(LAS u32x4*)(lds + F_KB0 + buf * F_KBS + row * KSTR + col * 16) = sr.k[i]; }
        } else {
            const int row = tid >> 3, col = tid & 7; *(LAS u32x4*)(lds + F_KB0 + buf * F_KBS + row * KSTR + col * 16) = sr.k[0];
        }
        if (!PASS2) {
#pragma unroll
            for (int i = 0; i < 2; ++i) { const int c = tid + i * 512, row = c >> 3, col = c & 7; *(LAS u32x4*)(lds + F_VB0 + buf * F_VBS + row * 144 + col * 16) = sr.v[i]; }
        }
        if (MODE == M_FOX) { if (tid < 64) *(LAS float*)(lds + F_CT + buf * 256 + tid * 4) = -sr.c * rsl2; }
    };
    int j = (MODE == M_SLC) ? next_sel(un, tile_lo - 1, tile_hi) : (MODE == M_FOX ? tile_hi : tile_lo);
    if (MODE != M_FOX && j > tile_hi) return;
    float carry = 0.f;
    load_tile(j); write_tile(0);
    __syncthreads();
    int buf = 0;
    for (;;) {
        const int jn = (MODE == M_SLC) ? next_sel(un, j, tile_hi) : (MODE == M_FOX ? j - 1 : j + 1);
        const bool has = (MODE == M_FOX) ? (jn >= tile_lo) : (jn <= tile_hi);
        if (has) load_tile(jn);
        bool dead = false;
        {
            const int kv0 = j * 64;
            const int pos_min = (MODE == M_CMP) ? 16 * kv0 + 31 : kv0;
            const int pos_max = (MODE == M_CMP) ? 16 * (kv0 + 63) + 31 : kv0 + 63;
            bool active = pos_min <= t_wmax;
            if (MODE == M_WIN) active = active && (t_wmin - pos_max < 512);
            bool selbit = true;
            if (MODE == M_SLC) {
                selbit = ((((const LAS unsigned*)impw)[j >> 5] >> (j & 31)) & 1u) != 0u;
                active = active && (__builtin_amdgcn_ballot_w64(selbit) != 0ull);
            }
            if (active) {
                f32x16 s0, s1;
                if (MODE == M_FOX) {
                    const LAS float* ct = (const LAS float*)(lds + F_CT + buf * 256) + 8 * g;
#pragma unroll
                    for (int q4 = 0; q4 < 4; ++q4) {
                        const f32x4 a = *(const LAS f32x4*)(ct + (q4 >> 1) * 16 + (q4 & 1) * 4), b = *(const LAS f32x4*)(ct + 32 + (q4 >> 1) * 16 + (q4 & 1) * 4);
#pragma unroll
                        for (int e = 0; e < 4; ++e) { s0[q4 * 4 + e] = a[e]; s1[q4 * 4 + e] = b[e]; }
                    }
                } else { s0 = (f32x16)(0.f); s1 = (f32x16)(0.f); }
                const LAS unsigned char* kb = lds + F_KB0 + buf * F_KBS + g * 16 + prow * KSTR;
                __builtin_amdgcn_s_setprio(1);
#pragma unroll
                for (int kk = 0; kk < DK / 16; ++kk) {
                    const bf16x8 a0 = *(const LAS bf16x8*)(kb + kk * 32);
                    const bf16x8 a1 = *(const LAS bf16x8*)(kb + 32 * KSTR + kk * 32);
                    s0 = mfma32(a0, qf[kk], s0); s1 = mfma32(a1, qf[kk], s1);
                }
                __builtin_amdgcn_s_setprio(0);
                const bool need_causal = pos_max > t_wmin;
                const bool need_bias = (MODE != M_FOX) && ((t_wmin - pos_max) < 128);
                const bool need_win = (MODE == M_WIN) && (t_wmax - pos_min >= 512);
                if (!PASS2 && !(need_causal || need_bias || need_win)) {
                    float mx = fmaxf(s0[0], s1[0]);
#pragma unroll
                    for (int r = 1; r < 16; ++r) mx = fmax3(mx, s0[r], s1[r]);
                    if (MODE == M_SLC) mx = selbit ? mx : NEG;
                    mx = xhalf_max(mx);
                    const float mxs = mx * sl2;
                    const float mn = (mxs > m_run + 8.0f) ? mxs : m_run;
                    const float alpha = fexp2(m_run - mn);
                    m_run = mn;
                    float nm = -mn;
                    if (MODE == M_SLC) nm = selbit ? nm : -__builtin_inff();
                    float ps0 = 0.f, ps1 = 0.f;
#pragma unroll
                    for (int r = 0; r < 16; ++r) {
                        s0[r] = fexp2(__builtin_fmaf(s0[r], sl2, nm)); s1[r] = fexp2(__builtin_fmaf(s1[r], sl2, nm));
                        ps0 += s0[r]; ps1 += s1[r];
                    }
                    l_run = l_run * alpha + (ps0 + ps1);
                    if (__builtin_amdgcn_ballot_w64(alpha != 1.0f) != 0ull) {
#pragma unroll
                        for (int db = 0; db < 4; ++db)
#pragma unroll
                            for (int r = 0; r < 16; ++r) O[db][r] *= alpha;
                    }
                } else {
#pragma unroll
                    for (int r = 0; r < 16; ++r) { s0[r] *= sl2; s1[r] *= sl2; }
                    if (need_bias || need_causal || need_win) {
#pragma unroll
                        for (int i = 0; i < 32; ++i) {
                            const int s = kv0 + (i >> 3) * 16 + 8 * g + (i & 7);
                            const int dist = t_lane - ((MODE == M_CMP) ? 16 * s + 31 : s);
                            float v = (i < 16) ? s0[i & 15] : s1[i & 15];
                            if (need_bias) { const int di = dist < 0 ? 0 : (dist > 128 ? 128 : dist); v += tb[di]; }
                            bool msk = dist < 0;
                            if (MODE == M_WIN) msk = msk || dist >= 512;
                            if (msk) v = NEG;
                            if (i < 16) s0[i & 15] = v; else s1[i & 15] = v;
                            if ((i & 7) == 7) __builtin_amdgcn_sched_barrier(0);
                        }
                    }
                    if (MODE == M_SLC) {
                        if (!selbit) {
#pragma unroll
                            for (int r = 0; r < 16; ++r) { s0[r] = NEG; s1[r] = NEG; }
                        }
                    }
                    if (!PASS2) {
                        float mx = fmaxf(s0[0], s1[0]);
#pragma unroll
                        for (int r = 1; r < 16; ++r) mx = fmax3(mx, s0[r], s1[r]);
                        mx = xhalf_max(mx);
                        const float mn = (mx > m_run + 8.0f) ? mx : m_run;
                        const float alpha = fexp2(m_run - mn);
                        m_run = mn;
                        float ps0 = 0.f, ps1 = 0.f;
#pragma unroll
                        for (int r = 0; r < 16; ++r) { s0[r] = fexp2(s0[r] - mn); s1[r] = fexp2(s1[r] - mn); ps0 += s0[r]; ps1 += s1[r]; }
                        l_run = l_run * alpha + (ps0 + ps1);
                        if (__builtin_amdgcn_ballot_w64(alpha != 1.0f) != 0ull) {
#pragma unroll
                            for (int db = 0; db < 4; ++db)
#pragma unroll
                                for (int r = 0; r < 16; ++r) O[db][r] *= alpha;
                        }
                    }
                }
                if (!PASS2) {
                    bf16x8 pf[4];
#pragma unroll
                    for (int k2 = 0; k2 < 4; ++k2) {
                        u32x4 pk;
#pragma unroll
                        for (int e = 0; e < 4; ++e) pk[e] = (k2 < 2) ? pack2(s0[(k2 & 1) * 8 + 2 * e], s0[(k2 & 1) * 8 + 2 * e + 1]) : pack2(s1[(k2 & 1) * 8 + 2 * e], s1[(k2 & 1) * 8 + 2 * e + 1]);
                        pf[k2] = __builtin_bit_cast(bf16x8, pk);
                    }
                    const LAS unsigned char* vb = lds + F_VB0 + buf * F_VBS + ql * 144 + g * 16;
                    __builtin_amdgcn_s_setprio(1);
#pragma unroll
                    for (int db = 0; db < 4; ++db)
#pragma unroll
                        for (int k2 = 0; k2 < 4; ++k2) {
                            const bf16x8 vf = *(const LAS bf16x8*)(vb + db * 32 * 144 + k2 * 32);
                            O[db] = mfma32(vf, pf[k2], O[db]);
                            if (k2 == 3 && (db & 1)) __builtin_amdgcn_sched_barrier(0);
                        }
                    __builtin_amdgcn_s_setprio(0);
                    if (MODE == M_FOX) {
                        if (has) { const float cn = cg2[jn * 64 + 63]; dead = __builtin_amdgcn_ballot_w64(!((qnb - cn) - m_run < -160.0f)) == 0ull; }
                    }
                } else {
                    float I0[4], I1[4], e7[4];
#pragma unroll
                    for (int c = 0; c < 4; ++c) {
                        float p[8];
#pragma unroll
                        for (int e = 0; e < 8; ++e) p[e] = fexp2(((c < 2) ? s0[(c & 1) * 8 + e] : s1[(c & 1) * 8 + e]) - m_run) * l_run;
                        I0[c] = (p[0] + p[1]) + (p[2] + p[3]);
                        I1[c] = (p[4] + p[5]) + (p[6] + p[7]) + p[3];
                        e7[c] = p[7];
                    }
                    float rc[4];
#pragma unroll
                    for (int c = 0; c < 4; ++c) rc[c] = __shfl_xor(e7[c], 32);
                    if (g == 1) {
#pragma unroll
                        for (int c = 0; c < 4; ++c) I0[c] += rc[c];
                    } else {
                        I0[0] += carry; I0[1] += rc[0]; I0[2] += rc[1]; I0[3] += rc[2];
                        carry = rc[3];
                    }
#pragma unroll
                    for (int c = 0; c < 4; ++c) {
                        I0[c] += dppf<0xB1>(I0[c]); I0[c] += dppf<0x4E>(I0[c]);
                        I1[c] += dppf<0xB1>(I1[c]); I1[c] += dppf<0x4E>(I1[c]);
                    }
                    if ((ql & 3) == 0) {
#pragma unroll
                        for (int c = 0; c < 4; ++c) {
                            impw[(ql >> 2) * 256 + 16 * j + 2 * g + 4 * c] = I0[c];
                            impw[(ql >> 2) * 256 + 16 * j + 2 * g + 4 * c + 1] = I1[c];
                        }
                    }
                }
            }
        }
        if (has) write_tile(buf ^ 1);
        if (MODE == M_FOX) { if (__syncthreads_and(dead ? 1 : 0)) break; }
        else __syncthreads();
        if (!has) break;
        j = jn; buf ^= 1;
    }
}

__device__ __forceinline__ void load_q128(bf16x8 (&qf)[8], const bfraw* qrow, int g) {
#pragma unroll
    for (int kk = 0; kk < 8; ++kk) qf[kk] = *(const bf16x8*)(qrow + kk * 16 + g * 8);
}

__device__ __forceinline__ void fox_item(CPR P, LAS unsigned char* lds, int h, int qb) {
    const bfraw* z = (const bfraw*)(P.ws + WS_Z); bfraw* mix = (bfraw*)(P.ws + WS_M);
    const float* c2 = (const float*)(P.ws + WS_C2) + (size_t)h * S;
    const int tid = otid(), wave = tid >> 6, lane = tid & 63, ql = lane & 31, g = lane >> 5;
    const int q0 = qb * 256, t = q0 + wave * 32 + ql;
    bf16x8 qf[8];
    load_q128(qf, z + Z0_FQK + ((size_t)h * S + t) * 128, g);
    float qn2 = 0.f;
#pragma unroll
    for (int kk = 0; kk < 8; ++kk)
#pragma unroll
        for (int e = 0; e < 8; ++e) { const float v = bf2f((unsigned short)qf[kk][e]); qn2 += v * v; }
    qn2 += __shfl_xor(qn2, 32);
    const float kmax2 = __uint_as_float(((const unsigned*)(P.ws + WS_KMAX))[h]);
    const float qnb = sqrtf(qn2 * kmax2) * (0.08838834764831845f * LOG2E * 1.01f) + 1.0f;
    f32x16 O[4];
#pragma unroll
    for (int i = 0; i < 4; ++i) O[i] = (f32x16)(0.f);
    float m = NEG, l = 0.f;
    __syncthreads();
    flash_loop<M_FOX, 128, false>(lds, z + Z0_FQK + (size_t)(8 + h) * S * 128, 128, z + Z0_VT + (size_t)(1024 + h * 128) * S, S, c2,
                                  0, (q0 + 255) >> 6, qf, t, q0 + wave * 32, q0 + wave * 32 + 31, 0.08838834764831845f * LOG2E,
                                  nullptr, qnb, O, m, l, nullptr);
    l += __shfl_xor(l, 32);
    const float inv = 1.0f / l;
    bfraw* orow = mix + (size_t)t * DM + 1024 + h * 128 + 4 * g;
#pragma unroll
    for (int db = 0; db < 4; ++db)
#pragma unroll
        for (int r4 = 0; r4 < 4; ++r4) {
            f32x4 v; v[0] = O[db][r4 * 4] * inv; v[1] = O[db][r4 * 4 + 1] * inv; v[2] = O[db][r4 * 4 + 2] * inv; v[3] = O[db][r4 * 4 + 3] * inv;
            st_bf4(orow + db * 32 + r4 * 8, v);
        }
}

__device__ __forceinline__ void diff_item(CPR P, LAS unsigned char* lds, int h, int qb) {
    const bfraw* z = (const bfraw*)(P.ws + WS_Z); bfraw* mix = (bfraw*)(P.ws + WS_M);
    const int tid = otid(), wave = tid >> 6, lane = tid & 63, ql = lane & 31, g = lane >> 5;
    const int q0 = qb * 256, t = q0 + wave * 32 + ql;
    const float* lam = P.in[9];
    const float sa = wsum(lam[lane] * lam[64 + lane]), sb = wsum(lam[128 + lane] * lam[192 + lane]);
    const float lmbda = __expf(sa) - __expf(sb) + LINIT;
    LAS float* tb = (LAS float*)(lds + F_TB);
    __syncthreads();
    build_t5(tb, P.in[15], h);
    __syncthreads();
    LAS unsigned* hold = (LAS unsigned*)(lds + F_IMP) + otid();
    f32x16 O[4];
    for (int mp = 0; mp < 2; ++mp) {
        bf16x8 qf[4];
        const bfraw* qrow = z + Z1_DQK + ((size_t)(h * 2 + mp) * S + t) * 64;
#pragma unroll
        for (int kk = 0; kk < 4; ++kk) qf[kk] = *(const bf16x8*)(qrow + kk * 16 + g * 8);
#pragma unroll
        for (int i = 0; i < 4; ++i) O[i] = (f32x16)(0.f);
        float m = NEG, l = 0.f;
        flash_loop<M_DIFF, 64, false>(lds, z + Z1_DQK + (size_t)(16 + h * 2 + mp) * S * 64, 64, z + Z1_VT + (size_t)(h * 128) * S, S, nullptr,
                                      0, (q0 + 255) >> 6, qf, t, q0 + wave * 32, q0 + wave * 32 + 31, 0.125f * LOG2E,
                                      tb, 0.f, O, m, l, nullptr);
        l += __shfl_xor(l, 32);
        const float inv = 1.0f / l;
        if (mp == 0) {
#pragma unroll
            for (int db = 0; db < 4; ++db)
#pragma unroll
                for (int r = 0; r < 8; ++r) hold[(db * 8 + r) * 512] = pack2(O[db][2 * r] * inv, O[db][2 * r + 1] * inv);
        } else {
            float ss = 0.f;
#pragma unroll
            for (int db = 0; db < 4; ++db)
#pragma unroll
                for (int r = 0; r < 8; ++r) {
                    const unsigned hv = hold[(db * 8 + r) * 512];
                    const float a = __uint_as_float(hv << 16) - lmbda * (O[db][2 * r] * inv);
                    const float b = __uint_as_float(hv & 0xffff0000u) - lmbda * (O[db][2 * r + 1] * inv);
                    O[db][2 * r] = a; O[db][2 * r + 1] = b;
                    ss += a * a + b * b;
                }
            ss += __shfl_xor(ss, 32);
            const float rn = rsqrtf(ss * (1.0f / 128.0f) + EPS) * (1.0f - LINIT);
            const float* sg = P.in[10];
            bfraw* orow = mix + (size_t)t * DM + h * 128 + 4 * g;
#pragma unroll
            for (int db = 0; db < 4; ++db)
#pragma unroll
                for (int r4 = 0; r4 < 4; ++r4) {
                    const f32x4 gv = *(const f32x4*)(sg + db * 32 + r4 * 8 + 4 * g);
                    f32x4 v;
#pragma unroll
                    for (int e = 0; e < 4; ++e) v[e] = O[db][r4 * 4 + e] * rn * gv[e];
                    st_bf4(orow + db * 32 + r4 * 8, v);
                }
        }
    }
}

template <int MODE>
__device__ __forceinline__ void nsa_item(CPR P, LAS unsigned char* lds, int h, int qb) {
    const bfraw* z = (const bfraw*)(P.ws + WS_Z); bfraw* mix = (bfraw*)(P.ws + WS_M);
    bfraw* ocmp = (bfraw*)(P.ws + WS_XB); bfraw* owin = ocmp + (size_t)S * 1024;
    const float* gates = (const float*)(P.ws + WS_GATES);
    const unsigned* selg = (const unsigned*)(P.ws + WS_SEL);
    const int tid = otid(), wave = tid >> 6, lane = tid & 63, ql = lane & 31, g = lane >> 5;
    const int q0 = qb * 256, t = q0 + wave * 32 + ql, kvh = h >> 2;
    LAS float* tb = (LAS float*)(lds + F_TB);
    LAS unsigned* un = (LAS unsigned*)(lds + F_UN);
    LAS unsigned* selL = (LAS unsigned*)(lds + F_IMP) + (wave * 32 + ql) * 9;
    __syncthreads();
    build_t5(tb, P.in[15], 8 + h);
    if (MODE == M_SLC) { if (tid < 8) un[tid] = 0u; }
    __syncthreads();
    if (MODE == M_SLC) {
        const u32x4 a = *(const u32x4*)(selg + ((size_t)t * 2 + kvh) * 8), b = *(const u32x4*)(selg + ((size_t)t * 2 + kvh) * 8 + 4);
        if (g == 0) {
#pragma unroll
            for (int q = 0; q < 4; ++q) { atomicOr((unsigned*)(un + q), a[q]); atomicOr((unsigned*)(un + 4 + q), b[q]); selL[q] = a[q]; selL[4 + q] = b[q]; }
        }
        __syncthreads();
    }
    bf16x8 qf[8];
    load_q128(qf, z + Z1_NQ + ((size_t)h * S + t) * 128, g);
    f32x16 O[4];
#pragma unroll
    for (int i = 0; i < 4; ++i) O[i] = (f32x16)(0.f);
    float m = NEG, l = 0.f;
    const int tile_hi = (q0 + 255) >> 6;
    if (MODE == M_WIN) {
        const int lo = q0 >= 511 ? (q0 - 511) >> 6 : 0;
        flash_loop<M_WIN, 128, false>(lds, z + Z1_WK + (size_t)kvh * S * 128, 128, z + Z1_VT + (size_t)(1280 + kvh * 128) * S, S, nullptr,
                                      lo, tile_hi, qf, t, q0 + wave * 32, q0 + wave * 32 + 31, 0.08838834764831845f * LOG2E, tb, 0.f, O, m, l, nullptr);
    } else {
        flash_loop<M_SLC, 128, false>(lds, z + Z1_SK + (size_t)kvh * S * 128, 128, z + Z1_VT + (size_t)(1024 + kvh * 128) * S, S, nullptr,
                                      0, tile_hi, qf, t, q0 + wave * 32, q0 + wave * 32 + 31, 0.08838834764831845f * LOG2E, tb, 0.f, O, m, l, (LAS float*)selL);
    }
    l += __shfl_xor(l, 32);
    const float gate = gates[(size_t)t * 24 + (MODE == M_WIN ? 16 : 8) + h];
    const float sc = gate / l;
    const size_t ob = (size_t)t * 1024 + h * 128 + 4 * g;
    u32x2 cq[16], wq[16];
    if (MODE == M_SLC) {
#pragma unroll
        for (int i = 0; i < 16; ++i) { const size_t o = ob + (i >> 2) * 32 + (i & 3) * 8; cq[i] = *(const u32x2*)(ocmp + o); wq[i] = *(const u32x2*)(owin + o); }
    }
#pragma unroll
    for (int db = 0; db < 4; ++db)
#pragma unroll
        for (int r4 = 0; r4 < 4; ++r4) {
            f32x4 v; v[0] = O[db][r4 * 4] * sc; v[1] = O[db][r4 * 4 + 1] * sc; v[2] = O[db][r4 * 4 + 2] * sc; v[3] = O[db][r4 * 4 + 3] * sc;
            const size_t o = ob + db * 32 + r4 * 8;
            if (MODE == M_WIN) st_bf4(owin + o, v);
            else {
                const u32x2 c = cq[db * 4 + r4], w = wq[db * 4 + r4];
                v[0] += __uint_as_float(c[0] << 16) + __uint_as_float(w[0] << 16);
                v[1] += __uint_as_float(c[0] & 0xffff0000u) + __uint_as_float(w[0] & 0xffff0000u);
                v[2] += __uint_as_float(c[1] << 16) + __uint_as_float(w[1] << 16);
                v[3] += __uint_as_float(c[1] & 0xffff0000u) + __uint_as_float(w[1] & 0xffff0000u);
                st_bf4(mix + (size_t)t * DM + 1024 + h * 128 + 4 * g + db * 32 + r4 * 8, v);
            }
        }
}

__device__ __forceinline__ void cmp_item(CPR P, LAS unsigned char* lds, int kvh, int qt) {
    const bfraw* z = (const bfraw*)(P.ws + WS_Z);
    bfraw* ocmp = (bfraw*)(P.ws + WS_XB);
    const float* gates = (const float*)(P.ws + WS_GATES);
    unsigned* selg = (unsigned*)(P.ws + WS_SEL);
    const bfraw* kc = (const bfraw*)(P.ws + WS_KC) + (size_t)kvh * 1024 * 128;
    const bfraw* vct = (const bfraw*)(P.ws + WS_VCT) + (size_t)kvh * 128 * 1024;
    const int tid = otid(), wave = tid >> 6, lane = tid & 63, ql = lane & 31, g = lane >> 5;
    const int q0 = qt * 64, t = q0 + wave * 8 + (ql >> 2), r = ql & 3, h = kvh * 4 + r;
    LAS float* tb4 = (LAS float*)(lds + F_TB);
    LAS float* impw = (LAS float*)(lds + F_IMP) + wave * 2048;
    __syncthreads();
    {
        const int hh = tid >> 7, d = tid & 127;
        const float* table = P.in[15];
        tb4[hh * 132 + d] = (table[t5_bucket(d) * 16 + 8 + kvh * 4 + hh] - table[31 * 16 + 8 + kvh * 4 + hh]) * LOG2E;
        if (d == 0) tb4[hh * 132 + 128] = 0.f;
    }
#pragma unroll
    for (int i = 0; i < 32; ++i) impw[i * 64 + lane] = 0.f;
    __syncthreads();
    bf16x8 qf[8];
    load_q128(qf, z + Z1_NQ + ((size_t)h * S + t) * 128, g);
    f32x16 O[4];
#pragma unroll
    for (int i = 0; i < 4; ++i) O[i] = (f32x16)(0.f);
    float m = NEG, l = 0.f;
    const int tmax = q0 + 63;
    const int tile_hi = tmax >= 31 ? ((tmax - 31) >> 4) >> 6 : -1;
    const float sl2 = 0.08838834764831845f * LOG2E;
    flash_loop<M_CMP, 128, false>(lds, kc, 128, vct, 1024, nullptr, 0, tile_hi, qf, t, q0 + wave * 8, q0 + wave * 8 + 7, sl2, tb4 + r * 132, 0.f, O, m, l, nullptr);
    l += __shfl_xor(l, 32);
    const bool valid = m > -1e29f;
    const float inv = valid ? 1.0f / l : 0.f;
    {
        const float sc = inv * gates[(size_t)t * 24 + h];
        bfraw* orow = ocmp + (size_t)t * 1024 + h * 128 + 4 * g;
#pragma unroll
        for (int db = 0; db < 4; ++db)
#pragma unroll
            for (int r4 = 0; r4 < 4; ++r4) {
                f32x4 v; v[0] = O[db][r4 * 4] * sc; v[1] = O[db][r4 * 4 + 1] * sc; v[2] = O[db][r4 * 4 + 2] * sc; v[3] = O[db][r4 * 4 + 3] * sc;
                if (!valid) v = (f32x4){0.f, 0.f, 0.f, 0.f};
                st_bf4(orow + db * 32 + r4 * 8, v);
            }
    }
    float m2 = valid ? m : 0.f, l2 = inv;
    flash_loop<M_CMP, 128, true>(lds, kc, 128, vct, 1024, nullptr, 0, tile_hi, qf, t, q0 + wave * 8, q0 + wave * 8 + 7, sl2, tb4 + r * 132, 0.f, O, m2, l2, impw);
    __syncthreads();
    {
        float sc[8][4]; unsigned sel[8];
#pragma unroll
        for (int qi = 0; qi < 8; ++qi) {
            const int tq = q0 + wave * 8 + qi, cur = tq >> 6;
            sel[qi] = 0u;
#pragma unroll
            for (int i = 0; i < 4; ++i) {
                const int jb = i * 64 + lane;
                const float imp = impw[qi * 256 + jb];
                const bool forced = (jb == 0) || (jb == cur) || (jb == cur - 1);
                sc[qi][i] = forced ? 1e9f : ((jb * 64 <= tq) ? imp : -1e9f);
            }
        }
        for (int it = 0; it < 16; ++it) {
            float bv[8]; int bj[8];
#pragma unroll
            for (int qi = 0; qi < 8; ++qi) {
                bv[qi] = -3e38f; bj[qi] = 1 << 20;
#pragma unroll
                for (int i = 0; i < 4; ++i) if (!((sel[qi] >> i) & 1u) && sc[qi][i] > bv[qi]) { bv[qi] = sc[qi][i]; bj[qi] = i * 64 + lane; }
            }
#pragma unroll
            for (int qi = 0; qi < 8; ++qi) wave_argmax(bv[qi], bj[qi]);
#pragma unroll
            for (int qi = 0; qi < 8; ++qi) if ((bj[qi] & 63) == lane) sel[qi] |= 1u << (bj[qi] >> 6);
        }
#pragma unroll
        for (int qi = 0; qi < 8; ++qi) {
            const int tq = q0 + wave * 8 + qi;
            unsigned long long b0 = __builtin_amdgcn_ballot_w64((sel[qi] & 1u) != 0), b1 = __builtin_amdgcn_ballot_w64((sel[qi] & 2u) != 0),
                               b2 = __builtin_amdgcn_ballot_w64((sel[qi] & 4u) != 0), b3 = __builtin_amdgcn_ballot_w64((sel[qi] & 8u) != 0);
            if (lane < 8) {
                const unsigned long long bb = (lane >> 1) == 0 ? b0 : ((lane >> 1) == 1 ? b1 : ((lane >> 1) == 2 ? b2 : b3));
                selg[((size_t)tq * 2 + kvh) * 8 + lane] = (lane & 1) ? (unsigned)(bb >> 32) : (unsigned)bb;
            }
        }
    }
}

__device__ __forceinline__ void cmp_mlp_item(CPR P, LAS unsigned char* lds, int kv, int kvh, int mt) {
    const bfraw* z = (const bfraw*)(P.ws + WS_Z); const bfraw* W = (const bfraw*)(P.ws + WS_W);
    const bfraw* src = z + (kv == 0 ? Z1_CK : Z1_CV) + (size_t)kvh * CKV_HS;
    const bfraw* w1t = W + W_C1 + (size_t)kv * 128 * 4096; const bfraw* w2t = W + W_C2 + (size_t)kv * 128 * 128;
    const float* pbias = (const float*)(P.ws + WS_PBIAS) + kv * 128;
    const int tid = otid(), w = tid >> 6, lane = tid & 63, ql = lane & 31, g = lane >> 5;
    LAS unsigned char* As = lds; LAS unsigned char* Bs = lds + 128 * T128;
    f32x16 acc[2]; acc[0] = (f32x16)(0.f); acc[1] = (f32x16)(0.f);
    for (int kc = 0; kc < 32; ++kc) {
        __syncthreads();
        stage128(As, src + (size_t)(mt * 128) * 2048 + kc * 128, 2048);
        stage128(Bs, w1t + kc * 128, 4096);
        __syncthreads();
        mm128(As, T128, Bs, T128, 128, acc);
    }
    __syncthreads();
#pragma unroll
    for (int nb = 0; nb < 2; ++nb)
#pragma unroll
        for (int r = 0; r < 16; ++r) {
            const int row = (w >> 1) * 32 + (r & 3) + 8 * (r >> 2) + 4 * g, col = (w & 1) * 64 + nb * 32 + ql;
            *(LAS bfraw*)(As + row * T128 + col * 2) = f2bf(siluf_(acc[nb][r] + pbias[col]));
        }
    stage128(Bs, w2t, 128);
    __syncthreads();
    acc[0] = (f32x16)(0.f); acc[1] = (f32x16)(0.f);
    mm128(As, T128, Bs, T128, 128, acc);
    bfraw* kcb = (bfraw*)(P.ws + WS_KC) + (size_t)kvh * 1024 * 128; bfraw* vcb = (bfraw*)(P.ws + WS_VCT) + (size_t)kvh * 128 * 1024;
#pragma unroll
    for (int nb = 0; nb < 2; ++nb)
#pragma unroll
        for (int r = 0; r < 16; ++r) {
            const int row = mt * 128 + (w >> 1) * 32 + (r & 3) + 8 * (r >> 2) + 4 * g, col = (w & 1) * 64 + nb * 32 + ql;
            const bfraw v = row < 1023 ? f2bf(acc[nb][r]) : (bfraw)0;
            if (kv == 0) kcb[(size_t)row * 128 + col] = v; else vcb[(size_t)col * 1024 + row] = v;
        }
}

constexpr int N_PHASES = 19;
#ifndef PH_MASK
#define PH_MASK 0x1FFFFFFu
#endif
#define PHON(n) (((PH_MASK) >> (n)) & 1u)
__device__ __forceinline__ void grid_barrier(unsigned* ctr, unsigned k, unsigned G) {
    __syncthreads();
    if (threadIdx.x == 0) {
        __builtin_amdgcn_fence(__ATOMIC_RELEASE, "agent");
        asm volatile("s_waitcnt vmcnt(0) lgkmcnt(0)" ::: "memory");
        const unsigned grp = blockIdx.x & 7u, gsize = (G - grp + 7u) >> 3;
        const unsigned old = __hip_atomic_fetch_add(ctr + 32 * grp, 1u, __ATOMIC_RELAXED, __HIP_MEMORY_SCOPE_AGENT);
        if (old + 1u == gsize * k) __hip_atomic_fetch_add(ctr + 32 * 8, 1u, __ATOMIC_RELAXED, __HIP_MEMORY_SCOPE_AGENT);
        const unsigned ngrp = G < 8u ? G : 8u;
        while (__hip_atomic_load(ctr + 32 * 8, __ATOMIC_RELAXED, __HIP_MEMORY_SCOPE_AGENT) < ngrp * k) __builtin_amdgcn_s_sleep(4);
        __builtin_amdgcn_fence(__ATOMIC_ACQUIRE, "agent");
        asm volatile("s_waitcnt vmcnt(0) lgkmcnt(0)" ::: "memory");
    }
    __syncthreads();
}
__device__ __forceinline__ int queue_pop(unsigned* qctr, LAS unsigned char* lds) {
    LAS int* slot = (LAS int*)(lds + LDS_BYTES - 64);
    __syncthreads();
    if (otid() == 0) slot[0] = (int)__hip_atomic_fetch_add(qctr, 1u, __ATOMIC_RELAXED, __HIP_MEMORY_SCOPE_AGENT);
    __syncthreads();
    return __builtin_amdgcn_readfirstlane(slot[0]);
}
template <int ph>
__device__ __forceinline__ void run_phase(LAS unsigned char* lds, int G, int bid, unsigned* bar_ctr, unsigned& nbar) {
        const __attribute__((address_space(4))) Params* Pp = (const __attribute__((address_space(4))) Params*)__builtin_amdgcn_kernarg_segment_ptr();
        asm volatile("" : "+s"(Pp));
        CPR P = *Pp;
        bfraw* W = (bfraw*)(P.ws + WS_W);
        bfraw* XB = (bfraw*)(P.ws + WS_XB); bfraw* Z = (bfraw*)(P.ws + WS_Z); bfraw* Mx = (bfraw*)(P.ws + WS_M); bfraw* PB = (bfraw*)(P.ws + WS_PB);
        float* ssq = (float*)(P.ws + WS_SSQ);
        switch (ph) {
        case 0: if (PHON(0)) { phase_conv(P, lds, 0); phase_prep(P); } break;
        case 1: if (PHON(1)) {
            pg8::Gemm gm; gm.A0 = XB; gm.Bt0 = W + W_IN; gm.A1 = W + W_IN + (size_t)5376 * DM; gm.Bt1 = XB; gm.K = DM;
            pg8::Sched2 sc; sc.init(S, 5120, 2048, S, G, bid);
            EpiZ e{(const float*)(P.ws + WS_RINV), Z, (float*)(P.ws + WS_FL), 0};
            pg8::gemm_phase(lds, gm, sc, e);
            fl_rows(P, lds);
        } break;
        case 2: if (PHON(2)) {
            unsigned* qctr = (unsigned*)(P.ws + WS_BAR) + 386;
            for (;;) {
                const int it = queue_pop(qctr, lds);
                if (it >= 8 + 64 + 1024) break;
                if (it < 8) fox_cumsum_item(P, lds, it);
                else if (it < 72) fox_kmax_item(P, lds, (it - 8) & 7, (it - 8) >> 3);
                else ret_upd_item(P, lds, (it - 72) >> 7, (it - 72) & 127);
            }
            }
            break;
        case 3: if (PHON(3)) phase_ret_scan(P); break;
        case 4: if (PHON(4)) {
            unsigned* qctr = (unsigned*)(P.ws + WS_BAR) + 384;
            LAS int* slot = (LAS int*)(lds + LDS_BYTES - 64);
            for (;;) {
                __syncthreads();
                if (otid() == 0) slot[0] = (int)__hip_atomic_fetch_add(qctr, 1u, __ATOMIC_RELAXED, __HIP_MEMORY_SCOPE_AGENT);
                __syncthreads();
                const int it = __builtin_amdgcn_readfirstlane(slot[0]);
                if (it >= 512 + 1024) break;
                if (it < 512) { if (PHON(22)) fox_item(P, lds, it & 7, 63 - (it >> 3)); }
                else { const int r = it - 512; if (PHON(21)) ret_out_item(P, lds, r >> 7, r & 127); }
            }
            }
            break;
        case 5: case 14: if (PHON(5)) {
            pg8::Gemm gm; gm.A0 = Mx; gm.Bt0 = W + W_OUT; gm.A1 = Mx; gm.Bt1 = W + W_OUT; gm.K = DM;
            pg8::Sched2 sc; sc.init(S, DM, 0, 0, G, bid);
            EpiRes e{ph == 5 ? P.in[0] : P.out, P.out, XB, ssq, 1};
            pg8::gemm_phase(lds, gm, sc, e);
        } break;
        case 6: case 15: if (PHON(6)) {
            {
                const int gt = bid * NTHREADS + otid();
                if (gt < S) ((float*)(P.ws + WS_RINV))[gt] = row_rinv(ssq, gt);
                nbar += 1u; grid_barrier(bar_ctr, nbar, (unsigned)G);
            }
            if (PHON(23)) {
                pg8::Gemm gm; gm.A0 = XB; gm.Bt0 = W + W_GU; gm.A1 = XB; gm.Bt1 = W + W_GU; gm.K = DM;
                pg8::Sched2 sc; sc.init(S, 2 * DFF, 0, 0, G, bid);
                EpiGU e{(const float*)(P.ws + WS_RINV), Z};
                pg8::gemm_phase(lds, gm, sc, e);
            }
            if (PHON(24)) {
                const bfraw* pbl = PB + (size_t)(ph == 6 ? 0 : 1) * S * PLE;
                pg8::Gemm gm; gm.A0 = pbl; gm.Bt0 = W + W_PP; gm.A1 = pbl; gm.Bt1 = W + W_PP; gm.K = PLE;
                pg8::Sched2 sc; sc.init(S, DM, 0, 0, G, bid);
                EpiPP e{Mx};
                pg8::gemm_phase(lds, gm, sc, e);
            }
        } break;
        case 7: case 16: if (PHON(7)) {
            pg8::Gemm gm; gm.A0 = Z; gm.Bt0 = W + W_D; gm.A1 = Z; gm.Bt1 = W + W_D; gm.K = DFF;
            pg8::Sched2 sc; sc.init(S, DM, 0, 0, G, bid);
            EpiRes e{P.out, P.out, XB, ssq, 0};
            pg8::gemm_phase(lds, gm, sc, e);
        } break;
        case 8: case 17: if (PHON(8)) {
            pg8::Gemm gm; gm.A0 = XB; gm.Bt0 = W + W_PG; gm.A1 = XB; gm.Bt1 = W + W_PG; gm.K = DM;
            pg8::Sched2 sc; sc.init(S, DM, 0, 0, G, bid);
            EpiPLE e{P.out, Mx, ssq};
            pg8::gemm_phase(lds, gm, sc, e);
        } break;
        case 9: if (PHON(9)) phase_conv(P, lds, 1); break;
        case 10: if (PHON(10)) {
            pg8::Gemm gm; gm.A0 = Mx; gm.Bt0 = W + W_IN; gm.A1 = W + W_IN + (size_t)4352 * DM; gm.Bt1 = Mx; gm.K = DM;
            pg8::Sched2 sc; sc.init(S, 4352, 1536, S, G, bid);
            EpiZ e{(const float*)(P.ws + WS_RINV), Z, (float*)(P.ws + WS_GATES), 1};
            pg8::gemm_phase(lds, gm, sc, e);
        } break;
        case 11: {
            if (PHON(11)) for (int it = bid; it < 32; it += G) cmp_mlp_item(P, lds, it >> 4, (it >> 3) & 1, it & 7);
            if (PHON(19)) for (int u = bid * 2; u < 512; u += (u & 1) ? 2 * G - 1 : 1) { const int h = (u >> 1) & 7, pr = u >> 4; diff_item(P, lds, h, (u & 1) ? pr : 63 - pr); }
            if (PHON(20)) {
                const int skip = G > 64 ? 32 : 0;
                if (bid >= skip) for (int it = bid - skip; it < 512; it += G - skip) nsa_item<M_WIN>(P, lds, it & 7, it >> 3);
            }
            } break;
        case 12: if (PHON(12))
            for (int u = bid * 2; u < 512; u += (u & 1) ? 2 * G - 1 : 1) { const int kvh = (u >> 1) & 1, pr = u >> 2; cmp_item(P, lds, kvh, (u & 1) ? pr : 255 - pr); }
            break;
        case 13: if (PHON(13)) {
            unsigned* qctr = (unsigned*)(P.ws + WS_BAR) + 389;
            for (;;) {
                const int it = queue_pop(qctr, lds);
                if (it >= 512) break;
                nsa_item<M_SLC>(P, lds, it & 7, 63 - (it >> 3));
            }
            }
            break;
        case 18: if (PHON(18)) phase_final(P); break;
        default: break;
        }
}
#ifndef PROBE_REP
#define PROBE_REP 0u
#endif
#define GSYNC() do { nbar += 1u; grid_barrier(bar_ctr, nbar, (unsigned)G); } while (0)
#define RUN_PH(n) do { if ((n) >= ph_lo && (n) < ph_hi) { if ((n) != ph_lo) { GSYNC(); } run_phase<(n)>(lds, G, bid, bar_ctr, nbar); \
                       if ((PROBE_REP >> (n)) & 1u) { GSYNC(); run_phase<(n)>(lds, G, bid, bar_ctr, nbar); } } } while (0)
__global__ void __launch_bounds__(NTHREADS, 2) fwd_megakernel(Params P0) {
    extern __shared__ __attribute__((aligned(16))) unsigned char shm[];
    LAS unsigned char* lds = (LAS unsigned char*)shm;
    cg::grid_group grid = cg::this_grid();
    const int G = gridDim.x, bid = blockIdx.x;
    const int ph_lo = P0.ph_lo, ph_hi = P0.ph_hi;
    unsigned* bar_ctr = (unsigned*)(P0.ws + WS_BAR); unsigned nbar = 0u;
    if (ph_hi < 0) grid.sync();
    RUN_PH(0); RUN_PH(1); RUN_PH(2); RUN_PH(3); RUN_PH(4); RUN_PH(5); RUN_PH(6); RUN_PH(7); RUN_PH(8); RUN_PH(9);
    RUN_PH(10); RUN_PH(11); RUN_PH(12); RUN_PH(13); RUN_PH(14); RUN_PH(15); RUN_PH(16); RUN_PH(17); RUN_PH(18);
}

extern "C" void kernel_launch(void* const* d_in, const int* in_sizes, int n_in, void* d_out, int out_size, void* d_ws, size_t ws_size, hipStream_t stream) {
    static int grid_blocks = 0;
    if (!grid_blocks) {
        int dev = 0, cus = 0, per_cu = 0;
        hipGetDevice(&dev);
        hipDeviceGetAttribute(&cus, hipDeviceAttributeMultiprocessorCount, dev);
        hipFuncSetAttribute((const void*)fwd_megakernel, hipFuncAttributeMaxDynamicSharedMemorySize, LDS_BYTES);
        hipOccupancyMaxActiveBlocksPerMultiprocessor(&per_cu, (const void*)fwd_megakernel, NTHREADS, LDS_BYTES);
        if (per_cu < 1) per_cu = 1;
        grid_blocks = cus * 1;
        if (ws_size < WS_END) fprintf(stderr, "kernel_launch: workspace too small: %zu < %zu\n", ws_size, (size_t)WS_END);
        (void)hipGetLastError();
    }
    (void)hipMemsetAsync((char*)d_ws + WS_BAR, 0, 2048, stream);
    Params p{};
    for (int i = 0; i < 22 && i < n_in; ++i) p.in[i] = (const float*)d_in[i];
    p.out = (float*)d_out; p.ws = (unsigned char*)d_ws; p.ph_lo = 0; p.ph_hi = N_PHASES;
    void* args[] = {&p};
    hipError_t e = hipLaunchCooperativeKernel((const void*)fwd_megakernel, dim3(grid_blocks), dim3(NTHREADS), args, LDS_BYTES, stream);
    if (e != hipSuccess) fprintf(stderr, "cooperative launch failed: %s (grid %d)\n", hipGetErrorString(e), grid_blocks);
}
```
